# Optimizing an MI355X kernel written in HIP

```python
import jax, jax.numpy as jnp
from jax import lax
import numpy as np

D_MODEL = 1024
BATCH = 4
SEQ = 4096
DEPTH = 2

CHUNK = 64
CONV_WIDTH = 3
D_CONV = 1024
D_GMLP = 1024
GMLP_BLOCK = 128
N_GROUPS_GMLP = 8
D_POOL = 1024
POOL_WINDOWS = (2, 4, 8, 16)
POOL_GROUP = D_POOL // len(POOL_WINDOWS)
N_BRANCHES = 3
D_FF = 2816
D_IN = 3 * D_CONV + 2 * D_GMLP + D_POOL + N_BRANCHES * D_MODEL
ALPHA = (2 * DEPTH) ** 0.25
BETA = (8 * DEPTH) ** -0.25
LN_EPS = 1e-5

kernel_name = "hybrid_conv_gmlp_pool_deepnorm_adaln"


def layer_norm(x, g, b):
    xf = x.astype(jnp.float32)
    mu = jnp.mean(xf, axis=-1, keepdims=True)
    var = jnp.mean(jnp.square(xf - mu), axis=-1, keepdims=True)
    y = (xf - mu) * lax.rsqrt(var + LN_EPS)
    return (y * g.astype(jnp.float32) + b.astype(jnp.float32)).astype(x.dtype)


def causal_dwconv(x, w):
    k, ch = w.shape
    return lax.conv_general_dilated(
        x, w[:, None, :].astype(x.dtype), window_strides=(1,), padding=[(k - 1, 0)],
        dimension_numbers=("NWC", "WIO", "NWC"), feature_group_count=ch)


def spatial_gating(u, v, ln_g, ln_b, w_s, b_s):
    bn, s, _ = v.shape
    v = layer_norm(v, ln_g, ln_b)
    vb = v.reshape(bn, s // GMLP_BLOCK, GMLP_BLOCK, N_GROUPS_GMLP, D_GMLP // N_GROUPS_GMLP)
    pos = jnp.arange(GMLP_BLOCK)
    allowed = (pos[None, :] // CHUNK) <= (pos[:, None] // CHUNK)
    w = jnp.where(allowed[None], w_s, jnp.zeros_like(w_s))
    mixed = jnp.einsum("gij,bnjgc->bnigc", w, vb) + b_s.T[None, None, :, :, None]
    return u * mixed.reshape(bn, s, D_GMLP)


def multiscale_pool(p, w_pool, scale):
    s = p.shape[1]
    pf = p.astype(jnp.float32)
    cs = jnp.cumsum(pf, axis=1)
    t = jnp.arange(1, s + 1, dtype=jnp.float32)
    outs = []
    for k, win in enumerate(POOL_WINDOWS):
        lo, hi = k * POOL_GROUP, (k + 1) * POOL_GROUP
        csk = cs[..., lo:hi]
        prev = jnp.pad(csk, ((0, 0), (win, 0), (0, 0)))[:, :s]
        mean = (csk - prev) / jnp.minimum(t, float(win))[None, :, None]
        d = (mean - pf[..., lo:hi]).astype(p.dtype)
        outs.append(d @ w_pool[k])
    return jnp.concatenate(outs, axis=-1) * scale


def setup_inputs(seed: int = 0) -> dict:
    key = jax.random.key(seed)
    ks = jax.random.split(key, 26)
    f32 = jnp.float32

    def nrm(k, shape, s):
        return jax.random.normal(k, shape, f32) * s

    L = DEPTH
    w_in_scale = D_MODEL ** -0.5
    return {
        "x": nrm(ks[0], (BATCH, SEQ, D_MODEL), 1.0),
        "c": nrm(ks[1], (BATCH, D_MODEL), 1.0),
        "w_ada": nrm(ks[2], (L, D_MODEL, 6 * D_MODEL), 0.5 * D_MODEL ** -0.5),
        "b_ada": nrm(ks[3], (L, 6 * D_MODEL), 0.02),
        "w_in": nrm(ks[4], (L, D_MODEL, D_IN), w_in_scale),
        "b_in": nrm(ks[5], (L, D_IN), 0.01),
        "conv_a": nrm(ks[6], (L, CONV_WIDTH, D_CONV), 0.5),
        "w_a_out": nrm(ks[7], (L, D_CONV, D_MODEL), D_CONV ** -0.5),
        "ln_v_g": 1.0 + nrm(ks[8], (L, D_GMLP), 0.02),
        "ln_v_b": nrm(ks[9], (L, D_GMLP), 0.02),
        "w_spatial": nrm(ks[10], (L, N_GROUPS_GMLP, GMLP_BLOCK, GMLP_BLOCK), 0.5 * GMLP_BLOCK ** -0.5),
        "b_spatial": 1.0 + nrm(ks[11], (L, N_GROUPS_GMLP, GMLP_BLOCK), 0.02),
        "w_b_out": nrm(ks[12], (L, D_GMLP, D_MODEL), D_GMLP ** -0.5),
        "w_pool": nrm(ks[13], (L, len(POOL_WINDOWS), POOL_GROUP, POOL_GROUP), POOL_GROUP ** -0.5),
        "pool_scale": 1.0 + nrm(ks[14], (L, D_POOL), 0.02),
        "w_o": nrm(ks[15], (L, D_MODEL, D_MODEL), BETA * D_MODEL ** -0.5),
        "ln1_g": 1.0 + nrm(ks[16], (L, D_MODEL), 0.02),
        "ln1_b": nrm(ks[17], (L, D_MODEL), 0.02),
        "w_up": nrm(ks[18], (L, D_MODEL, 2 * D_FF), w_in_scale),
        "b_up": nrm(ks[19], (L, 2 * D_FF), 0.01),
        "conv_ffn": nrm(ks[20], (L, CONV_WIDTH, D_FF), 0.5),
        "conv_ffn_b": nrm(ks[21], (L, D_FF), 0.01),
        "w_down": nrm(ks[22], (L, D_FF, D_MODEL), BETA * D_FF ** -0.5),
        "ln2_g": 1.0 + nrm(ks[23], (L, D_MODEL), 0.02),
        "ln2_b": nrm(ks[24], (L, D_MODEL), 0.02),
    }


def reference(x, c, w_ada, b_ada, w_in, b_in, conv_a, w_a_out, ln_v_g, ln_v_b,
              w_spatial, b_spatial, w_b_out, w_pool, pool_scale, w_o, ln1_g, ln1_b,
              w_up, b_up, conv_ffn, conv_ffn_b, w_down, ln2_g, ln2_b):
    split_points = [D_CONV, 2 * D_CONV, 3 * D_CONV, 3 * D_CONV + D_GMLP,
                    3 * D_CONV + 2 * D_GMLP, 3 * D_CONV + 2 * D_GMLP + D_POOL]
    c_act = jax.nn.silu(c)
    for l in range(DEPTH):
        ada = (c_act @ w_ada[l] + b_ada[l])[:, None, :]
        sh1, sc1, gt1, sh2, sc2, gt2 = jnp.split(ada, 6, axis=-1)

        h = x * (1.0 + sc1) + sh1
        z = h @ w_in[l] + b_in[l]
        zb, zc, zx, zu, zv, zp, zg = jnp.split(z, split_points, axis=-1)
        y_a = (zb * causal_dwconv(zc * zx, conv_a[l])) @ w_a_out[l]
        y_b = spatial_gating(jax.nn.gelu(zu), jax.nn.gelu(zv), ln_v_g[l], ln_v_b[l],
                             w_spatial[l], b_spatial[l]) @ w_b_out[l]
        y_c = multiscale_pool(zp, w_pool[l], pool_scale[l])
        g_a, g_b, g_c = jnp.split(jax.nn.sigmoid(zg), 3, axis=-1)
        merged = g_a * y_a + g_b * y_b + g_c * y_c
        x = layer_norm(ALPHA * x + gt1 * (merged @ w_o[l]), ln1_g[l], ln1_b[l])

        h = x * (1.0 + sc2) + sh2
        up_a, up_g = jnp.split(h @ w_up[l] + b_up[l], 2, axis=-1)
        f = jax.nn.gelu(causal_dwconv(up_a, conv_ffn[l]) + conv_ffn_b[l]) * up_g
        x = layer_norm(ALPHA * x + gt2 * (f @ w_down[l]), ln2_g[l], ln2_b[l])
    return x
```

```cpp
#include <hip/hip_runtime.h>
#include <hip/hip_cooperative_groups.h>
#include <cstdio>
namespace cg = cooperative_groups;

#ifndef MK_ONE_LAUNCH
#define MK_ONE_LAUNCH 1
#endif

#define LAS __attribute__((address_space(3)))
typedef unsigned short bf16_t;
typedef short bf16x8 __attribute__((ext_vector_type(8)));
typedef float f32x4 __attribute__((ext_vector_type(4)));
typedef unsigned u32x4 __attribute__((ext_vector_type(4)));
typedef unsigned u32x2 __attribute__((ext_vector_type(2)));

constexpr int MTOK = 16384, DM = 1024, SEQ = 4096, NBATCH = 4, DIN = 9216, DFF = 2816, DEPTH = 2;
constexpr float ALPHA = 1.4142135623730951f;
constexpr float LN_EPS = 1e-5f;

constexpr size_t MiB = (size_t)1 << 20;
constexpr size_t WS_W1G = 0;
constexpr size_t WS_WA = 18 * MiB;
constexpr size_t WS_WB = 20 * MiB;
constexpr size_t WS_WP = 22 * MiB;
constexpr size_t WS_WO = 24 * MiB;
constexpr size_t WS_WUP = 26 * MiB;
constexpr size_t WS_WD = 37 * MiB;
constexpr size_t WS_WSP = 42 * MiB + 512 * 1024;
constexpr size_t WS_ADA = 44 * MiB;
constexpr size_t WS_B1P = 44 * MiB + 256 * 1024;
constexpr size_t WS_STATS = 45 * MiB;
constexpr size_t WS_H = 48 * MiB;
constexpr size_t WS_S0 = 80 * MiB;
constexpr size_t SLOT = 32 * MiB;
constexpr size_t WS_END = WS_S0 + 6 * SLOT;

constexpr int LDS_BYTES = 131072 + 256;
constexpr int NTHREADS = 512;

struct Args {
    const float* in[25];
    float* out;
    unsigned char* ws;
    int ph_lo, ph_hi;
};

struct LArgs { const float* in[25]; float* out; unsigned char* ws; };
template <class T> __device__ __forceinline__ T* uniform_ptr(T* p) {
    const unsigned long long v = (unsigned long long)p;
    const unsigned lo = __builtin_amdgcn_readfirstlane((unsigned)v), hi = __builtin_amdgcn_readfirstlane((unsigned)(v >> 32));
    return (T*)(((unsigned long long)hi << 32) | lo);
}
__device__ __forceinline__ int tid_() { int t = threadIdx.x; asm volatile("" : "+v"(t)); return t; }
#define IN(i) uniform_ptr(a.in[i])

enum { I_X = 0, I_C, I_WADA, I_BADA, I_WIN, I_BIN, I_CONVA, I_WAOUT, I_LNVG, I_LNVB, I_WSP, I_BSP, I_WBOUT, I_WPOOL, I_PSCALE, I_WO, I_LN1G, I_LN1B,
       I_WUP, I_BUP, I_CONVF, I_CONVFB, I_WDOWN, I_LN2G, I_LN2B };

__device__ __forceinline__ float bf_lo(unsigned w) { return __uint_as_float(w << 16); }
__device__ __forceinline__ float bf_hi(unsigned w) { return __uint_as_float(w & 0xffff0000u); }
__device__ __forceinline__ unsigned pk_bf16(float lo, float hi) { unsigned r; asm("v_cvt_pk_bf16_f32 %0, %1, %2" : "=v"(r) : "v"(lo), "v"(hi)); return r; }
__device__ __forceinline__ float gelu_tanh(float x) {
    const float u2 = x * (1.5957691216f + 0.0713548163f * x * x);
    const float e = __builtin_amdgcn_exp2f(-1.4426950409f * u2);
    return x * __builtin_amdgcn_rcpf(1.0f + e);
}
__device__ __forceinline__ float sigmoid_f(float x) { const float e = __builtin_amdgcn_exp2f(-1.4426950409f * x); return __builtin_amdgcn_rcpf(1.0f + e); }
__device__ __forceinline__ void unpack8(const u32x4 w, float (&f)[8]) {
    f[0] = bf_lo(w.x); f[1] = bf_hi(w.x); f[2] = bf_lo(w.y); f[3] = bf_hi(w.y); f[4] = bf_lo(w.z); f[5] = bf_hi(w.z); f[6] = bf_lo(w.w); f[7] = bf_hi(w.w);
}
__device__ __forceinline__ u32x4 pack8(const float (&f)[8]) { u32x4 w; w.x = pk_bf16(f[0], f[1]); w.y = pk_bf16(f[2], f[3]); w.z = pk_bf16(f[4], f[5]); w.w = pk_bf16(f[6], f[7]); return w; }

constexpr int BM = 256, BK = 64, HALF = 128, HTB = HALF * BK * 2;
__device__ __forceinline__ int lds_byte(int r, int c) { const int st = (r >> 4) * 2 + (c >> 5), rr = r & 15, cc = c & 31, ob = rr * 64 + cc * 2; return st * 1024 + (ob ^ (((ob >> 9) & 1) << 5)); }
__device__ __forceinline__ void stage_rc(int b, int& R, int& C) { const int st = b / 1024, sb = b % 1024, swz = sb ^ (((sb >> 9) & 1) << 5); R = (st >> 1) * 16 + swz / 64; C = (st & 1) * 32 + (swz % 64) / 2; }
__device__ __forceinline__ int perm32(int rho) { const int n = rho >> 4, i = rho & 15; return 8 * (i >> 2) + 4 * n + (i & 3); }

enum { K_STORE = 0, K_ZCX = 1, K_BR = 2, K_RES = 3 };
enum { ACT_NONE = 0, ACT_GELU = 1, ACT_SIGMOID = 2, ACT_STATS = 4 };

struct Unit {
    const char* A; const char* B;
    int nt, kind, pm, pn;
    bf16_t* dst;
    const float* bias;
    int ldd, act;
};

__device__ __forceinline__ bool static_tile(int nM, int nN, long L, int& pm, int& pn) {
    const int nwg = nM * nN; if (L >= nwg) return false;
    int wgid = (int)L; { const int q = nwg / 8, r = nwg % 8, xcd = wgid % 8, off = wgid / 8; wgid = (xcd < r ? xcd * (q + 1) : r * (q + 1) + (xcd - r) * q) + off; }
    const int nig = 8 * nN, gid = wgid / nig, fm = gid * 8, gsz = (nM - fm) < 8 ? (nM - fm) : 8;
    pm = fm + ((wgid % nig) % gsz); pn = (wgid % nig) / gsz; return true;
}

enum { GM_G1 = 0, GM_BR, GM_WO, GM_UP, GM_DOWN };
struct GSched {
    int mode, G, c, layer;
    unsigned char* ws;
    __device__ __forceinline__ bool next(int i, Unit& u) const {
        const size_t ROWB = 256 * 1024 * 2;
        if (mode == GM_G1) {
            if (!static_tile(64, 24, (long)i * G + c, u.pm, u.pn)) return false;
            u.A = (const char*)(ws + WS_H) + (size_t)u.pm * ROWB; u.B = (const char*)(ws + WS_W1G) + (size_t)u.pn * ROWB; u.nt = 16;
            u.bias = (const float*)(ws + WS_B1P) + u.pn * 256; u.ldd = 1024; u.kind = K_STORE; u.act = ACT_NONE;
            const int pn = u.pn;
            if (pn < 4) { u.dst = (bf16_t*)(ws + WS_S0) + pn * 256; }
            else if (pn < 12) { u.kind = K_ZCX; u.dst = (bf16_t*)(ws + WS_S0 + SLOT) + (pn - 4) * 128; }
            else if (pn < 16) { u.act = ACT_GELU; u.dst = (bf16_t*)(ws + WS_S0 + 2 * SLOT) + (pn - 12) * 256; }
            else if (pn < 20) { u.act = ACT_GELU | ACT_STATS; u.dst = (bf16_t*)(ws + WS_S0 + 3 * SLOT) + (pn - 16) * 256; }
            else { u.dst = (bf16_t*)(ws + WS_S0 + 4 * SLOT) + (pn - 20) * 256; }
            return true;
        } else if (mode == GM_BR) {
            const int ti = i / 6, step = i - ti * 6;
            if (!static_tile(64, 4, (long)ti * G + c, u.pm, u.pn)) return false;
            const int br = step >> 1;
            u.nt = 16; u.ldd = 1024;
            if ((step & 1) == 0) {
                u.A = (const char*)(ws + WS_H) + (size_t)u.pm * ROWB; u.B = (const char*)(ws + WS_W1G) + (size_t)(24 + br * 4 + u.pn) * ROWB;
                u.kind = K_STORE; u.act = ACT_SIGMOID; u.dst = (bf16_t*)(ws + WS_S0 + SLOT) + u.pn * 256; u.bias = (const float*)(ws + WS_B1P) + 6144 + br * 1024 + u.pn * 256;
            } else {
                u.kind = K_BR; u.act = br; u.dst = (bf16_t*)(ws + WS_S0 + SLOT) + u.pn * 256; u.bias = (const float*)(ws + WS_S0 + 3 * SLOT) + u.pn * 256;
                if (br == 0) { u.A = (const char*)(ws + WS_S0) + (size_t)u.pm * ROWB; u.B = (const char*)(ws + WS_WA) + (size_t)u.pn * ROWB; }
                else if (br == 1) { u.A = (const char*)(ws + WS_S0 + 2 * SLOT) + (size_t)u.pm * ROWB; u.B = (const char*)(ws + WS_WB) + (size_t)u.pn * ROWB; }
                else { u.A = (const char*)(ws + WS_S0 + 5 * SLOT) + (size_t)u.pm * ROWB + (size_t)u.pn * 512; u.B = (const char*)(ws + WS_WP) + (size_t)u.pn * ROWB + (size_t)u.pn * 512; u.nt = 4; }
            }
            return true;
        } else if (mode == GM_WO) {
            if (!static_tile(64, 4, (long)i * G + c, u.pm, u.pn)) return false;
            u.A = (const char*)(ws + WS_S0 + SLOT) + (size_t)u.pm * ROWB; u.B = (const char*)(ws + WS_WO) + (size_t)u.pn * ROWB; u.nt = 16;
            u.kind = K_RES; u.act = 0; u.dst = nullptr; u.bias = nullptr; u.ldd = 1024; return true;
        } else if (mode == GM_UP) {
            if (!static_tile(64, 22, (long)i * G + c, u.pm, u.pn)) return false;
            u.A = (const char*)(ws + WS_H) + (size_t)u.pm * ROWB; u.B = (const char*)(ws + WS_WUP) + (size_t)u.pn * ROWB; u.nt = 16;
            u.kind = K_STORE; u.act = ACT_NONE; u.ldd = DFF; u.bias = nullptr;
            u.dst = (u.pn < 11) ? (bf16_t*)(ws + WS_S0) + u.pn * 256 : (bf16_t*)(ws + WS_S0 + 3 * SLOT) + (u.pn - 11) * 256;
            return true;
        } else {
            if (!static_tile(64, 4, (long)i * G + c, u.pm, u.pn)) return false;
            u.A = (const char*)(ws + WS_S0 + 3 * SLOT) + (size_t)u.pm * (256 * (size_t)DFF * 2); u.B = (const char*)(ws + WS_WD) + (size_t)u.pn * (256 * (size_t)DFF * 2); u.nt = DFF / 64;
            u.kind = K_RES; u.act = 0; u.dst = nullptr; u.bias = nullptr; u.ldd = 1024; return true;
        }
    }
};

struct Epi {
    const float* up_bias;
    const float* pscale;
    const float* gt;
    const float* xres;
    float* yout;
    float2* stats;
    __device__ __forceinline__ void operator()(const f32x4 (&acc)[2][2][4][2], const Unit& u, int wr, int wc, int fr, int fq) const {
        const int cb = wc * 32 + fq * 8;
        const int row0 = u.pm * BM + wr * 64 + fr;
        if (u.kind == K_STORE) {
            const float* bp = (up_bias ? up_bias + u.pn * 256 : u.bias) + cb;
            const f32x4 b00 = *(const f32x4*)(bp), b01 = *(const f32x4*)(bp + 4), b10 = *(const f32x4*)(bp + 128), b11 = *(const f32x4*)(bp + 132);
            const int act = u.act & 3; const bool do_stats = (u.act & ACT_STATS) != 0;
#pragma unroll
            for (int ai = 0; ai < 2; ++ai)
#pragma unroll
                for (int m = 0; m < 4; ++m) {
                    const int row = row0 + ai * HALF + m * 16;
                    bf16_t* rowp = u.dst + (size_t)row * u.ldd + cb;
                    float s = 0.f, ss = 0.f;
#pragma unroll
                    for (int bj = 0; bj < 2; ++bj) {
                        f32x4 v0 = acc[ai][bj][m][0] + (bj ? b10 : b00), v1 = acc[ai][bj][m][1] + (bj ? b11 : b01);
                        if (act == ACT_GELU) {
#pragma unroll
                            for (int j = 0; j < 4; ++j) { v0[j] = gelu_tanh(v0[j]); v1[j] = gelu_tanh(v1[j]); }
                        } else if (act == ACT_SIGMOID) {
#pragma unroll
                            for (int j = 0; j < 4; ++j) { v0[j] = sigmoid_f(v0[j]); v1[j] = sigmoid_f(v1[j]); }
                        }
                        if (do_stats) {
#pragma unroll
                            for (int j = 0; j < 4; ++j) { s += v0[j] + v1[j]; ss += v0[j] * v0[j] + v1[j] * v1[j]; }
                        }
                        u32x4 w; w.x = pk_bf16(v0[0], v0[1]); w.y = pk_bf16(v0[2], v0[3]); w.z = pk_bf16(v1[0], v1[1]); w.w = pk_bf16(v1[2], v1[3]);
                        *(u32x4*)(rowp + bj * HALF) = w;
                    }
                    if (do_stats) {
                        s += __shfl_xor(s, 16); s += __shfl_xor(s, 32); ss += __shfl_xor(ss, 16); ss += __shfl_xor(ss, 32);
                        if (fq == 0) stats[(size_t)row * 16 + (u.pn - 16) * 4 + wc] = make_float2(s, ss);
                    }
                }
        } else if (u.kind == K_ZCX) {
            const float* bp = u.bias + cb;
            const f32x4 b00 = *(const f32x4*)(bp), b01 = *(const f32x4*)(bp + 4), b10 = *(const f32x4*)(bp + 128), b11 = *(const f32x4*)(bp + 132);
#pragma unroll
            for (int ai = 0; ai < 2; ++ai)
#pragma unroll
                for (int m = 0; m < 4; ++m) {
                    const int row = row0 + ai * HALF + m * 16;
                    const f32x4 p0 = (acc[ai][0][m][0] + b00) * (acc[ai][1][m][0] + b10), p1 = (acc[ai][0][m][1] + b01) * (acc[ai][1][m][1] + b11);
                    u32x4 w; w.x = pk_bf16(p0[0], p0[1]); w.y = pk_bf16(p0[2], p0[3]); w.z = pk_bf16(p1[0], p1[1]); w.w = pk_bf16(p1[2], p1[3]);
                    *(u32x4*)(u.dst + (size_t)row * 1024 + cb) = w;
                }
        } else if (u.kind == K_BR) {
            const int step = u.act;
            float* tm = (float*)u.bias;
            f32x4 sc[2][2];
#pragma unroll
            for (int bj = 0; bj < 2; ++bj)
#pragma unroll
                for (int n = 0; n < 2; ++n) sc[bj][n] = (step == 2) ? *(const f32x4*)(pscale + u.pn * 256 + bj * HALF + cb + 4 * n) : (f32x4){1.f, 1.f, 1.f, 1.f};
#pragma unroll
            for (int ai = 0; ai < 2; ++ai)
#pragma unroll
                for (int m = 0; m < 4; ++m) {
                    const int row = row0 + ai * HALF + m * 16;
#pragma unroll
                    for (int bj = 0; bj < 2; ++bj) {
                        const size_t off = (size_t)row * 1024 + bj * HALF + cb;
                        const u32x4 gw = *(const u32x4*)(u.dst + off);
                        float g[8]; unpack8(gw, g);
                        f32x4 t0 = (f32x4){g[0], g[1], g[2], g[3]} * sc[bj][0] * acc[ai][bj][m][0];
                        f32x4 t1 = (f32x4){g[4], g[5], g[6], g[7]} * sc[bj][1] * acc[ai][bj][m][1];
                        if (step != 0) { t0 += *(const f32x4*)(tm + off); t1 += *(const f32x4*)(tm + off + 4); }
                        if (step != 2) { *(f32x4*)(tm + off) = t0; *(f32x4*)(tm + off + 4) = t1; }
                        else { u32x4 w; w.x = pk_bf16(t0[0], t0[1]); w.y = pk_bf16(t0[2], t0[3]); w.z = pk_bf16(t1[0], t1[1]); w.w = pk_bf16(t1[2], t1[3]); *(u32x4*)(u.dst + off) = w; }
                    }
                }
        } else {
            const float* gp = gt + (u.pm >> 4) * 6144 + u.pn * 256 + cb;
            f32x4 gv[2][2];
#pragma unroll
            for (int bj = 0; bj < 2; ++bj)
#pragma unroll
                for (int n = 0; n < 2; ++n) gv[bj][n] = *(const f32x4*)(gp + bj * HALF + 4 * n);
#pragma unroll
            for (int ai = 0; ai < 2; ++ai)
#pragma unroll
                for (int m = 0; m < 4; ++m) {
                    const int row = row0 + ai * HALF + m * 16;
#pragma unroll
                    for (int bj = 0; bj < 2; ++bj) {
                        const size_t off = (size_t)row * 1024 + u.pn * 256 + bj * HALF + cb;
                        const f32x4 x0 = *(const f32x4*)(xres + off), x1 = *(const f32x4*)(xres + off + 4);
                        *(f32x4*)(yout + off) = x0 * ALPHA + gv[bj][0] * acc[ai][bj][m][0];
                        *(f32x4*)(yout + off + 4) = x1 * ALPHA + gv[bj][1] * acc[ai][bj][m][1];
                    }
                }
        }
    }
};

__device__ __forceinline__ void gemm_phase(LAS unsigned char* lds, const int lda, const int ldb, const GSched& S, const Epi& E) {
    const int tid = tid_(), wid = __builtin_amdgcn_readfirstlane(tid >> 6), lane = tid & 63, wr = wid >> 2, wc = wid & 3, fr = lane & 15, fq = lane >> 4;
    unsigned voffA[2], voffB[2];
#pragma unroll
    for (int i = 0; i < 2; ++i) { int R, C; stage_rc(tid * 16 + i * 8192, R, C); const int Rb = (R & ~31) + perm32(R & 31);
        voffA[i] = (unsigned)(R * lda + C) * 2u; voffB[i] = (unsigned)(Rb * ldb + C) * 2u; }
    const size_t kstep = (size_t)(BK * 2);
    const size_t hstepA = (size_t)HALF * lda * 2, hstepB = (size_t)HALF * ldb * 2;
    const unsigned ldsw = (unsigned)wid * 1024u;
    const int aoff = lds_byte(wr * 64 + fr, fq * 8), boff = lds_byte(wc * 32 + fr, fq * 8);
#define PG8_SA(b, h) (((b) * 2 + (h)) * HTB)
#define PG8_SB(b, h) ((4 + (b) * 2 + (h)) * HTB)
#define PG8_STAGE(bufoff, gbase, voff) do { _Pragma("unroll") for (int _i = 0; _i < 2; ++_i) \
        __builtin_amdgcn_global_load_lds((const unsigned*)((const char*)(gbase) + (voff)[_i]), (LAS unsigned*)(lds + (bufoff) + ldsw + _i * 8192), 16, 0, 0); } while (0)
#define PG8_LDA(dst, b, h) do { _Pragma("unroll") for (int m = 0; m < 4; ++m) _Pragma("unroll") for (int k = 0; k < 2; ++k) dst[m][k] = *(const LAS bf16x8*)(lds + PG8_SA(b, h) + aoff + m * 2048 + k * 1024); } while (0)
#define PG8_LDB(dst, b, h) do { _Pragma("unroll") for (int n = 0; n < 2; ++n) _Pragma("unroll") for (int k = 0; k < 2; ++k) dst[n][k] = *(const LAS bf16x8*)(lds + PG8_SB(b, h) + boff + n * 2048 + k * 1024); } while (0)
#define PG8_MMA(ai, bj, At, Bt) do { __builtin_amdgcn_s_setprio(1); _Pragma("unroll") for (int m = 0; m < 4; ++m) _Pragma("unroll") for (int n = 0; n < 2; ++n) _Pragma("unroll") for (int k = 0; k < 2; ++k) \
        acc[ai][bj][m][n] = __builtin_amdgcn_mfma_f32_16x16x32_bf16(Bt[n][k], At[m][k], acc[ai][bj][m][n], 0, 0, 0); __builtin_amdgcn_s_setprio(0); } while (0)
#define PG8_WAIT_V(n) asm volatile("s_waitcnt vmcnt(" #n ")" ::: "memory")
#define PG8_WAIT_L(n) asm volatile("s_waitcnt lgkmcnt(" #n ")" ::: "memory")
#define PG8_BAR __builtin_amdgcn_s_barrier()
#define PG8_SCHED __builtin_amdgcn_sched_barrier(0)
    Unit cur, nxt; int ui = 0;
    if (!S.next(0, cur)) return;
    f32x4 acc[2][2][4][2];
#pragma unroll
    for (int a = 0; a < 2; ++a)
#pragma unroll
        for (int b = 0; b < 2; ++b)
#pragma unroll
            for (int m = 0; m < 4; ++m)
#pragma unroll
                for (int n = 0; n < 2; ++n) acc[a][b][m][n] = (f32x4){0.f, 0.f, 0.f, 0.f};
    bf16x8 At[4][2], B0[2][2], B1[2][2];
    const char* cA = cur.A; const char* cB = cur.B;
    PG8_STAGE(PG8_SB(0, 0), cB, voffB); PG8_STAGE(PG8_SA(0, 0), cA, voffA); PG8_STAGE(PG8_SB(0, 1), cB + hstepB, voffB); PG8_STAGE(PG8_SA(0, 1), cA + hstepA, voffA);
    if (wr == 1) PG8_BAR;
    PG8_WAIT_V(4); PG8_BAR;
    PG8_STAGE(PG8_SB(1, 0), cB + kstep, voffB); PG8_STAGE(PG8_SA(1, 0), cA + kstep, voffA); PG8_STAGE(PG8_SB(1, 1), cB + hstepB + kstep, voffB);
    PG8_WAIT_V(6); PG8_BAR;
    for (;;) {
        const bool has_next = S.next(ui + 1, nxt);
        const char* nA = has_next ? nxt.A : cA; const char* nB = has_next ? nxt.B : cB;
        const int nt = cur.nt;
        for (int t = 0; t < nt; t += 2) {
            const bool last = (t == nt - 2);
            const char* a1 = cA + (size_t)(t + 1) * kstep;
            const char* a2 = last ? nA : cA + (size_t)(t + 2) * kstep; const char* b2 = last ? nB : cB + (size_t)(t + 2) * kstep;
            const char* a3 = a2 + kstep; const char* b3 = b2 + kstep;
            PG8_LDB(B0, 0, 0); PG8_SCHED; PG8_LDA(At, 0, 0); PG8_STAGE(PG8_SA(1, 1), a1 + hstepA, voffA);
            PG8_WAIT_L(8); PG8_BAR; PG8_WAIT_L(0); PG8_MMA(0, 0, At, B0); PG8_BAR; PG8_SCHED;
            PG8_LDB(B1, 0, 1); PG8_STAGE(PG8_SB(0, 0), b2, voffB);
            PG8_BAR; PG8_WAIT_L(0); PG8_MMA(0, 1, At, B1); PG8_BAR;
            PG8_LDA(At, 0, 1); PG8_STAGE(PG8_SA(0, 0), a2, voffA);
            PG8_BAR; PG8_WAIT_L(0); PG8_MMA(1, 0, At, B0); PG8_BAR; PG8_SCHED;
            PG8_STAGE(PG8_SB(0, 1), b2 + hstepB, voffB);
            PG8_WAIT_V(6); PG8_BAR; PG8_MMA(1, 1, At, B1); PG8_BAR;
            PG8_LDB(B0, 1, 0); PG8_SCHED; PG8_LDA(At, 1, 0); PG8_STAGE(PG8_SA(0, 1), a2 + hstepA, voffA);
            PG8_WAIT_L(8); PG8_BAR; PG8_WAIT_L(0); PG8_MMA(0, 0, At, B0); PG8_BAR; PG8_SCHED;
            PG8_LDB(B1, 1, 1); PG8_STAGE(PG8_SB(1, 0), b3, voffB);
            PG8_BAR; PG8_WAIT_L(0); PG8_MMA(0, 1, At, B1); PG8_BAR;
            PG8_LDA(At, 1, 1); PG8_STAGE(PG8_SA(1, 0), a3, voffA);
            PG8_BAR; PG8_WAIT_L(0); PG8_MMA(1, 0, At, B0); PG8_BAR; PG8_SCHED;
            PG8_STAGE(PG8_SB(1, 1), b3 + hstepB, voffB);
            PG8_WAIT_V(6); PG8_BAR; PG8_MMA(1, 1, At, B1); PG8_BAR;
        }
        E(acc, cur, wr, wc, fr, fq);
        if (!has_next) break;
#pragma unroll
        for (int a = 0; a < 2; ++a)
#pragma unroll
            for (int b = 0; b < 2; ++b)
#pragma unroll
                for (int m = 0; m < 4; ++m)
#pragma unroll
                    for (int n = 0; n < 2; ++n) acc[a][b][m][n] = (f32x4){0.f, 0.f, 0.f, 0.f};
        cur = nxt; cA = nA; cB = nB; ++ui;
    }
    PG8_WAIT_V(0);
    if (wr == 0) PG8_BAR;
    PG8_BAR;
#undef PG8_SA
#undef PG8_SB
#undef PG8_STAGE
#undef PG8_LDA
#undef PG8_LDB
#undef PG8_MMA
#undef PG8_WAIT_V
#undef PG8_WAIT_L
#undef PG8_BAR
#undef PG8_SCHED
}

__device__ __forceinline__ void conv_tile(const float* __restrict__ src, int ldn, int k0, int n0, bf16_t* __restrict__ dst, int ldk, int drow0, int dcol0, float* tile) {
    const int tid = tid_();
    {
        const int nn4 = (tid & 15) * 4, kk = tid >> 4;
#pragma unroll
        for (int p = 0; p < 2; ++p) {
            const int k = kk + 32 * p;
            const f32x4 v = *(const f32x4*)(src + (size_t)(k0 + k) * ldn + n0 + nn4);
            float* tp = tile + k * 65 + nn4; tp[0] = v[0]; tp[1] = v[1]; tp[2] = v[2]; tp[3] = v[3];
        }
    }
    __syncthreads();
    {
        const int nn = tid >> 3, kc = (tid & 7) * 8;
        float f[8];
#pragma unroll
        for (int e = 0; e < 8; ++e) f[e] = tile[(kc + e) * 65 + nn];
        *(u32x4*)(dst + (size_t)(drow0 + nn) * ldk + dcol0 + k0 + kc) = pack8(f);
    }
    __syncthreads();
}

constexpr int PREP_TILES = 2304 + 3 * 256 + 64 + 1408 + 704;
constexpr int PREP_MISC = 32 + 1;
constexpr int ADA_UNITS = 192;

__device__ __forceinline__ void prep_unit(const LArgs& a, int layer, int t, unsigned char* smem) {
    unsigned char* ws = uniform_ptr(a.ws);
    float* tile = (float*)smem;
    const int tid = tid_();
    if (t < 2304) {
        const int kt = t & 15, ntile = t >> 4, n0 = ntile * 64;
        int r;
        if (n0 < 1024) r = n0;
        else if (n0 < 2048) { const int ch = n0 - 1024; r = 1024 + 256 * (ch >> 7) + (ch & 127); }
        else if (n0 < 3072) { const int ch = n0 - 2048; r = 1024 + 256 * (ch >> 7) + 128 + (ch & 127); }
        else r = n0;
        conv_tile(IN(I_WIN) + (size_t)layer * DM * DIN, DIN, kt * 64, n0, (bf16_t*)(ws + WS_W1G), 1024, r, 0, tile); return;
    }
    t -= 2304;
    if (t < 768) {
        const int which = t >> 8, tt = t & 255, kt = tt & 15, ntile = tt >> 4;
        const float* src = (which == 0 ? IN(I_WAOUT) : which == 1 ? IN(I_WBOUT) : IN(I_WO)) + (size_t)layer * DM * DM;
        bf16_t* dst = (bf16_t*)(ws + (which == 0 ? WS_WA : which == 1 ? WS_WB : WS_WO));
        conv_tile(src, 1024, kt * 64, ntile * 64, dst, 1024, ntile * 64, 0, tile); return;
    }
    t -= 768;
    if (t < 64) {
        const int g = t >> 4, r = t & 15, kt = r & 3, ntile = r >> 2;
        conv_tile(IN(I_WPOOL) + (size_t)(layer * 4 + g) * 65536, 256, kt * 64, ntile * 64, (bf16_t*)(ws + WS_WP), 1024, 256 * g + ntile * 64, 256 * g, tile); return;
    }
    t -= 64;
    if (t < 1408) {
        const int kt = t & 15, ntile = t >> 4;
        conv_tile(IN(I_WUP) + (size_t)layer * DM * 2 * DFF, 2 * DFF, kt * 64, ntile * 64, (bf16_t*)(ws + WS_WUP), 1024, ntile * 64, 0, tile); return;
    }
    t -= 1408;
    if (t < 704) {
        const int kt = t % 44, ntile = t / 44;
        conv_tile(IN(I_WDOWN) + (size_t)layer * DFF * DM, 1024, kt * 64, ntile * 64, (bf16_t*)(ws + WS_WD), DFF, ntile * 64, 0, tile); return;
    }
    t -= 704;
    if (t < 32) {
        const int e0 = t * 4096 + tid * 8;
        const float* src = IN(I_WSP) + (size_t)layer * 131072 + e0;
        const f32x4 v0 = *(const f32x4*)src, v1 = *(const f32x4*)(src + 4);
        const int i = (e0 >> 7) & 127, j = e0 & 127;
        const bool ok = (j >> 6) <= (i >> 6);
        float f[8] = {v0[0], v0[1], v0[2], v0[3], v1[0], v1[1], v1[2], v1[3]};
        if (!ok) {
#pragma unroll
            for (int e = 0; e < 8; ++e) f[e] = 0.f;
        }
        *(u32x4*)((bf16_t*)(ws + WS_WSP) + e0) = pack8(f); return;
    }
    t -= 32;
    {
        const float* bin = IN(I_BIN) + (size_t)layer * DIN; float* b1p = (float*)(ws + WS_B1P);
        for (int r = tid; r < DIN; r += NTHREADS) {
            int src;
            if (r < 1024 || r >= 3072) src = r;
            else { const int rr = r - 1024, q = rr >> 8, w = rr & 255; src = (w < 128) ? 1024 + 128 * q + w : 2048 + 128 * q + (w - 128); }
            b1p[r] = bin[src];
        }
    }
}

__device__ __forceinline__ void ada_unit(const LArgs& a, int u, unsigned char* smem) {
    const int tid = tid_(), wid = tid >> 6, lane = tid & 63;
    float* sc = (float*)smem;
    float* red = (float*)(smem + 16384);
    const int layer = u / 96, n0 = (u % 96) * 64;
    for (int i = tid; i < 4096; i += NTHREADS) { const float c = IN(I_C)[i]; sc[i] = c * sigmoid_f(c); }
    __syncthreads();
    const float* w = IN(I_WADA) + (size_t)layer * DM * 6144 + n0 + lane;
    float acc0 = 0.f, acc1 = 0.f, acc2 = 0.f, acc3 = 0.f;
    const int kb = wid * 128;
#pragma unroll 8
    for (int k = 0; k < 128; ++k) {
        const float wv = w[(size_t)(kb + k) * 6144];
        acc0 += sc[kb + k] * wv; acc1 += sc[1024 + kb + k] * wv; acc2 += sc[2048 + kb + k] * wv; acc3 += sc[3072 + kb + k] * wv;
    }
    red[(wid * 4 + 0) * 64 + lane] = acc0; red[(wid * 4 + 1) * 64 + lane] = acc1; red[(wid * 4 + 2) * 64 + lane] = acc2; red[(wid * 4 + 3) * 64 + lane] = acc3;
    __syncthreads();
    if (tid < 256) {
        const int b = tid >> 6, n = tid & 63; float s = 0.f;
#pragma unroll
        for (int ww = 0; ww < 8; ++ww) s += red[(ww * 4 + b) * 64 + n];
        ((float*)(uniform_ptr(a.ws) + WS_ADA))[(size_t)(layer * 4 + b) * 6144 + n0 + n] = s + IN(I_BADA)[(size_t)layer * 6144 + n0 + n];
    }
    __syncthreads();
}

__device__ __forceinline__ void modulate_phase(const LArgs& a) {
    const float* x = IN(I_X); const float* ada = (const float*)(uniform_ptr(a.ws) + WS_ADA); bf16_t* H = (bf16_t*)(uniform_ptr(a.ws) + WS_H);
    const size_t nchunks = (size_t)MTOK * DM / 8;
    const int tid0 = tid_();
    for (size_t i = (size_t)blockIdx.x * NTHREADS + tid0; i < nchunks; i += (size_t)gridDim.x * NTHREADS) {
        const size_t e = i * 8; const int row = (int)(e >> 10), col = (int)(e & 1023), b = row >> 12;
        const f32x4 x0 = *(const f32x4*)(x + e), x1 = *(const f32x4*)(x + e + 4);
        const float* sh = ada + (size_t)b * 6144 + col; const float* sc = sh + 1024;
        const f32x4 s0 = *(const f32x4*)sc, s1 = *(const f32x4*)(sc + 4), h0 = *(const f32x4*)sh, h1 = *(const f32x4*)(sh + 4);
        const f32x4 y0 = x0 * (s0 + 1.0f) + h0, y1 = x1 * (s1 + 1.0f) + h1;
        u32x4 w; w.x = pk_bf16(y0[0], y0[1]); w.y = pk_bf16(y0[2], y0[3]); w.z = pk_bf16(y1[0], y1[1]); w.w = pk_bf16(y1[2], y1[3]);
        *(u32x4*)(H + e) = w;
    }
}

__device__ __forceinline__ void ln_phase(float* buf, const float* g, const float* bta, const float* mod_sh, const float* mod_sc, bf16_t* H) {
    const int tid = tid_(), wid = tid >> 6, lane = tid & 63;
    for (int row = blockIdx.x * 8 + wid; row < MTOK; row += gridDim.x * 8) {
        float* rp = buf + (size_t)row * DM + lane * 4;
        f32x4 v[4];
#pragma unroll
        for (int c = 0; c < 4; ++c) v[c] = *(const f32x4*)(rp + c * 256);
        float s = 0.f;
#pragma unroll
        for (int c = 0; c < 4; ++c) s += (v[c][0] + v[c][1]) + (v[c][2] + v[c][3]);
#pragma unroll
        for (int o = 32; o >= 1; o >>= 1) s += __shfl_xor(s, o);
        const float mean = s * (1.0f / 1024.0f);
        float q = 0.f;
#pragma unroll
        for (int c = 0; c < 4; ++c) { v[c] -= mean; q += (v[c][0] * v[c][0] + v[c][1] * v[c][1]) + (v[c][2] * v[c][2] + v[c][3] * v[c][3]); }
#pragma unroll
        for (int o = 32; o >= 1; o >>= 1) q += __shfl_xor(q, o);
        const float rstd = rsqrtf(q * (1.0f / 1024.0f) + LN_EPS);
        const int b = row >> 12;
#pragma unroll
        for (int c = 0; c < 4; ++c) {
            const int col = c * 256 + lane * 4;
            const f32x4 o = v[c] * rstd * *(const f32x4*)(g + col) + *(const f32x4*)(bta + col);
            *(f32x4*)(rp + c * 256) = o;
            if (H) {
                const f32x4 hh = o * (*(const f32x4*)(mod_sc + (size_t)b * 6144 + col) + 1.0f) + *(const f32x4*)(mod_sh + (size_t)b * 6144 + col);
                u32x2 w; w.x = pk_bf16(hh[0], hh[1]); w.y = pk_bf16(hh[2], hh[3]);
                *(u32x2*)(H + (size_t)row * DM + col) = w;
            }
        }
    }
}

__device__ __forceinline__ void conv3_gate_unit(const bf16_t* src, const bf16_t* gate, bf16_t* out, int ld, int R0, int C0, const float* w3, int wld, const float* bias, bool act_gelu) {
    const int tid = tid_(), cth = tid & 15, rth = tid >> 4;
    const int c = C0 + cth * 8, t0 = R0 + rth * 4, ts = t0 & (SEQ - 1);
    float w0[8], w1[8], w2[8], bb[8];
#pragma unroll
    for (int e = 0; e < 8; ++e) { w0[e] = w3[c + e]; w1[e] = w3[wld + c + e]; w2[e] = w3[2 * wld + c + e]; bb[e] = bias ? bias[c + e] : 0.f; }
    float xm2[8], xm1[8];
    if (ts >= 2) { unpack8(*(const u32x4*)(src + (size_t)(t0 - 2) * ld + c), xm2); unpack8(*(const u32x4*)(src + (size_t)(t0 - 1) * ld + c), xm1); }
    else {
#pragma unroll
        for (int e = 0; e < 8; ++e) { xm2[e] = 0.f; xm1[e] = 0.f; }
    }
#pragma unroll
    for (int r = 0; r < 4; ++r) {
        float x0[8], gg[8], o[8];
        unpack8(*(const u32x4*)(src + (size_t)(t0 + r) * ld + c), x0);
        unpack8(*(const u32x4*)(gate + (size_t)(t0 + r) * ld + c), gg);
#pragma unroll
        for (int e = 0; e < 8; ++e) {
            float v = w0[e] * xm2[e] + w1[e] * xm1[e] + w2[e] * x0[e] + bb[e];
            if (act_gelu) v = gelu_tanh(v);
            o[e] = gg[e] * v; xm2[e] = xm1[e]; xm1[e] = x0[e];
        }
        *(u32x4*)(out + (size_t)(t0 + r) * ld + c) = pack8(o);
    }
}

__device__ __forceinline__ void pool_unit(const bf16_t* zp, bf16_t* dout, int R0, int C0) {
    const int tid = tid_(), cth = tid & 15, rth = tid >> 4;
    const int c = C0 + cth * 8, t0 = R0 + rth * 4, ts0 = t0 & (SEQ - 1);
    const int win = 2 << (C0 >> 8);
    float s[8];
#pragma unroll
    for (int e = 0; e < 8; ++e) s[e] = 0.f;
    for (int k = 1; k < win; ++k) {
        if (ts0 - k >= 0) { float x[8]; unpack8(*(const u32x4*)(zp + (size_t)(t0 - k) * DM + c), x);
#pragma unroll
            for (int e = 0; e < 8; ++e) s[e] += x[e]; }
    }
#pragma unroll
    for (int r = 0; r < 4; ++r) {
        const int ts = ts0 + r;
        float x[8], o[8]; unpack8(*(const u32x4*)(zp + (size_t)(t0 + r) * DM + c), x);
        const float inv = 1.0f / (float)((ts + 1) < win ? (ts + 1) : win);
#pragma unroll
        for (int e = 0; e < 8; ++e) { s[e] += x[e]; o[e] = s[e] * inv - x[e]; }
        *(u32x4*)(dout + (size_t)(t0 + r) * DM + c) = pack8(o);
        if (ts - win + 1 >= 0) { float y[8]; unpack8(*(const u32x4*)(zp + (size_t)(t0 + r - win + 1) * DM + c), y);
#pragma unroll
            for (int e = 0; e < 8; ++e) s[e] -= y[e]; }
    }
}

__device__ __forceinline__ void spatial_unit(const LArgs& a, int layer, int rb, int g, unsigned char* smem) {
    unsigned char* ws = uniform_ptr(a.ws);
    const int tid = tid_(), wid = tid >> 6, lane = tid & 63;
    float* smu = (float*)smem; float* srs = smu + 128;
    bf16_t* VT = (bf16_t*)(smem + 1024);
    constexpr int LDT = 136;
    const int R0 = rb * 128, C0 = g * 128;
    const bf16_t* V = (const bf16_t*)(ws + WS_S0 + 3 * SLOT);
    bf16_t* U = (bf16_t*)(ws + WS_S0 + 2 * SLOT);
    if (tid < 128) {
        const float2* st = (const float2*)(ws + WS_STATS) + (size_t)(R0 + tid) * 16;
        float s = 0.f, ss = 0.f;
#pragma unroll
        for (int k = 0; k < 16; ++k) { const float2 p = st[k]; s += p.x; ss += p.y; }
        const float mu = s * (1.0f / 1024.0f); float var = ss * (1.0f / 1024.0f) - mu * mu; var = var > 0.f ? var : 0.f;
        smu[tid] = mu; srs[tid] = rsqrtf(var + LN_EPS);
    }
    __syncthreads();
    {
        const int cth = tid & 15, jth = tid >> 4;
        const float* lg = IN(I_LNVG) + (size_t)layer * 1024 + C0 + cth * 8; const float* lb = IN(I_LNVB) + (size_t)layer * 1024 + C0 + cth * 8;
        float gg[8], bb[8];
#pragma unroll
        for (int e = 0; e < 8; ++e) { gg[e] = lg[e]; bb[e] = lb[e]; }
#pragma unroll
        for (int p = 0; p < 4; ++p) {
            const int j = jth + 32 * p;
            float x[8]; unpack8(*(const u32x4*)(V + (size_t)(R0 + j) * DM + C0 + cth * 8), x);
            const float mu = smu[j], rs = srs[j];
#pragma unroll
            for (int e = 0; e < 8; e += 2) {
                const float y0 = (x[e] - mu) * rs * gg[e] + bb[e], y1 = (x[e + 1] - mu) * rs * gg[e + 1] + bb[e + 1];
                const unsigned w = pk_bf16(y0, y1);
                VT[(cth * 8 + e) * LDT + j] = (bf16_t)(w & 0xffffu); VT[(cth * 8 + e + 1) * LDT + j] = (bf16_t)(w >> 16);
            }
        }
    }
    __syncthreads();
    {
        const int wcg = wid & 3, wig = wid >> 2, n = lane & 15, q = lane >> 4;
        const bf16_t* W = (const bf16_t*)(ws + WS_WSP) + (size_t)g * 16384;
        f32x4 acc[2][4];
#pragma unroll
        for (int ct = 0; ct < 2; ++ct)
#pragma unroll
            for (int it = 0; it < 4; ++it) acc[ct][it] = (f32x4){0.f, 0.f, 0.f, 0.f};
#pragma unroll
        for (int ks = 0; ks < 4; ++ks) {
            const int k0 = ks * 32;
            bf16x8 af[2], bfr[4];
#pragma unroll
            for (int ct = 0; ct < 2; ++ct) af[ct] = *(const bf16x8*)(VT + (wcg * 32 + ct * 16 + n) * LDT + k0 + q * 8);
#pragma unroll
            for (int it = 0; it < 4; ++it) bfr[it] = *(const bf16x8*)(W + (wig * 64 + it * 16 + n) * 128 + k0 + q * 8);
#pragma unroll
            for (int ct = 0; ct < 2; ++ct)
#pragma unroll
                for (int it = 0; it < 4; ++it) acc[ct][it] = __builtin_amdgcn_mfma_f32_16x16x32_bf16(af[ct], bfr[it], acc[ct][it], 0, 0, 0);
        }
        const float* bsp = IN(I_BSP) + (size_t)layer * 1024 + g * 128;
#pragma unroll
        for (int it = 0; it < 4; ++it) {
            const int i = wig * 64 + it * 16 + n; const float bs = bsp[i];
#pragma unroll
            for (int ct = 0; ct < 2; ++ct) {
                bf16_t* up = U + (size_t)(R0 + i) * DM + C0 + wcg * 32 + ct * 16 + q * 4;
                const u32x2 uw = *(const u32x2*)up;
                u32x2 ow; ow.x = pk_bf16(bf_lo(uw.x) * (acc[ct][it][0] + bs), bf_hi(uw.x) * (acc[ct][it][1] + bs));
                ow.y = pk_bf16(bf_lo(uw.y) * (acc[ct][it][2] + bs), bf_hi(uw.y) * (acc[ct][it][3] + bs));
                *(u32x2*)up = ow;
            }
        }
    }
    __syncthreads();
}

constexpr int N_PHASES = 2 + 9 * DEPTH;

__device__ __forceinline__ void run_phase(const LArgs& a, int ph, unsigned char* smem) {
    asm volatile("" ::: "memory");
    unsigned char* ws = uniform_ptr(a.ws); float* aout = uniform_ptr(a.out);
    const int G = gridDim.x, bid = blockIdx.x;
    const float* ada = (const float*)(ws + WS_ADA);
    if (ph == 0) {
        const int total = ADA_UNITS + PREP_TILES + PREP_MISC;
        for (int u = bid; u < total; u += G) { if (u < ADA_UNITS) ada_unit(a, u, smem); else prep_unit(a, 0, u - ADA_UNITS, smem); }
        return;
    }
    if (ph == 1) { modulate_phase(a); return; }
    const int l = (ph - 2) / 9, sub = (ph - 2) % 9;
    const float* xin = (l == 0) ? IN(I_X) : aout;
    if (sub == 0 || sub == 2 || sub == 3 || sub == 5 || sub == 7) {
        GSched S; S.G = G; S.c = bid; S.layer = l; S.ws = ws;
        Epi E; E.up_bias = nullptr; E.pscale = IN(I_PSCALE) + (size_t)l * 1024; E.gt = nullptr; E.xres = nullptr; E.yout = aout; E.stats = (float2*)(ws + WS_STATS);
        int lda = 1024, ldb = 1024;
        if (sub == 0) S.mode = GM_G1;
        else if (sub == 2) S.mode = GM_BR;
        else if (sub == 3) { S.mode = GM_WO; E.gt = ada + (size_t)l * 4 * 6144 + 2048; E.xres = xin; }
        else if (sub == 5) { S.mode = GM_UP; E.up_bias = IN(I_BUP) + (size_t)l * 2 * DFF; }
        else { S.mode = GM_DOWN; E.gt = ada + (size_t)l * 4 * 6144 + 5120; E.xres = aout; lda = DFF; ldb = DFF; }
        gemm_phase((LAS unsigned char*)smem, lda, ldb, S, E);
        return;
    }
    if (sub == 1) {
        for (int u = bid; u < 3072; u += G) {
            const int type = u >> 10, v = u & 1023, rb = v >> 3, cgp = v & 7;
            if (type == 0) conv3_gate_unit((const bf16_t*)(ws + WS_S0 + SLOT), (const bf16_t*)(ws + WS_S0), (bf16_t*)(ws + WS_S0), 1024, rb * 128, cgp * 128, IN(I_CONVA) + (size_t)l * 3 * 1024, 1024, nullptr, false);
            else if (type == 1) spatial_unit(a, l, rb, cgp, smem);
            else pool_unit((const bf16_t*)(ws + WS_S0 + 4 * SLOT), (bf16_t*)(ws + WS_S0 + 5 * SLOT), rb * 128, cgp * 128);
        }
        return;
    }
    if (sub == 4) {
        ln_phase(aout, IN(I_LN1G) + (size_t)l * 1024, IN(I_LN1B) + (size_t)l * 1024, ada + (size_t)l * 4 * 6144 + 3072, ada + (size_t)l * 4 * 6144 + 4096, (bf16_t*)(ws + WS_H));
        return;
    }
    if (sub == 6) {
        for (int u = bid; u < 128 * 22; u += G) {
            const int rb = u / 22, cgp = u % 22;
            conv3_gate_unit((const bf16_t*)(ws + WS_S0), (const bf16_t*)(ws + WS_S0 + 3 * SLOT), (bf16_t*)(ws + WS_S0 + 3 * SLOT), DFF, rb * 128, cgp * 128, IN(I_CONVF) + (size_t)l * 3 * DFF, DFF, IN(I_CONVFB) + (size_t)l * DFF, true);
        }
        return;
    }
    {
        const bool more = (l + 1 < DEPTH);
        ln_phase(aout, IN(I_LN2G) + (size_t)l * 1024, IN(I_LN2B) + (size_t)l * 1024, ada + (size_t)(l + 1) * 4 * 6144, ada + (size_t)(l + 1) * 4 * 6144 + 1024, more ? (bf16_t*)(ws + WS_H) : nullptr);
        if (more) { const int total = PREP_TILES + PREP_MISC; for (int u = bid; u < total; u += G) prep_unit(a, l + 1, u, smem); }
    }
}

__global__ void __launch_bounds__(NTHREADS, 2) fwd_kernel(Args a) {
    extern __shared__ __attribute__((aligned(16))) unsigned char smem[];
#if MK_ONE_LAUNCH
    cg::grid_group grid = cg::this_grid();
#endif
    LArgs* la = (LArgs*)(smem + 131072);
    if (threadIdx.x == 0) {
#pragma unroll
        for (int i = 0; i < 25; ++i) la->in[i] = a.in[i];
        la->out = a.out; la->ws = a.ws;
    }
    __syncthreads();
    const int ph_lo = a.ph_lo, ph_hi = a.ph_hi;
    for (int ph = ph_lo; ph < ph_hi; ++ph) {
        run_phase(*la, ph, smem);
#if MK_ONE_LAUNCH
        if (ph + 1 < ph_hi) { __threadfence(); grid.sync(); }
#endif
    }
}

extern "C" void kernel_launch(void* const* d_in, const int* in_sizes, int n_in, void* d_out, int out_size, void* d_ws, size_t ws_size, hipStream_t stream) {
    static int grid = 0;
    if (grid == 0) {
        if (n_in != 25 || in_sizes[0] != MTOK * DM || out_size != MTOK * DM || ws_size < WS_END) {
            fprintf(stderr, "kernel_launch: unexpected shapes / workspace (n_in %d, in0 %d, out %d, ws %zu < %zu)\n", n_in, n_in > 0 ? in_sizes[0] : -1, out_size, ws_size, (size_t)WS_END);
            grid = -1; return;
        }
        int dev = 0, cus = 0, per_cu = 0;
        hipGetDevice(&dev);
        hipDeviceGetAttribute(&cus, hipDeviceAttributeMultiprocessorCount, dev);
        hipFuncSetAttribute((const void*)fwd_kernel, hipFuncAttributeMaxDynamicSharedMemorySize, LDS_BYTES);
        hipOccupancyMaxActiveBlocksPerMultiprocessor(&per_cu, (const void*)fwd_kernel, NTHREADS, LDS_BYTES);
        if (per_cu < 1) { fprintf(stderr, "kernel_launch: occupancy query says %d blocks/CU\n", per_cu); per_cu = 1; }
        (void)hipGetLastError();
        grid = cus;
        if (grid > cus * per_cu) grid = cus * per_cu;
    }
    if (grid < 0) return;
    Args a{};
    for (int i = 0; i < 25; ++i) a.in[i] = (const float*)d_in[i];
    a.out = (float*)d_out; a.ws = (unsigned char*)d_ws;
#if MK_ONE_LAUNCH
    a.ph_lo = 0; a.ph_hi = N_PHASES;
    void* args[] = {&a};
    hipError_t e = hipLaunchCooperativeKernel((const void*)fwd_kernel, dim3(grid), dim3(NTHREADS), args, LDS_BYTES, stream);
    if (e != hipSuccess) fprintf(stderr, "cooperative launch failed: %s (grid %d)\n", hipGetErrorString(e), grid);
#else
    for (int ph = 0; ph < N_PHASES; ++ph) {
        a.ph_lo = ph; a.ph_hi = ph + 1;
        hipLaunchKernelGGL(fwd_kernel, dim3(grid), dim3(NTHREADS), LDS_BYTES, stream, a);
    }
#endif
}
```

```cpp
#include <hip/hip_runtime.h>
#include <hip/hip_cooperative_groups.h>
#include <cstdio>
namespace cg = cooperative_groups;

#ifndef MK_ONE_LAUNCH
#define MK_ONE_LAUNCH 1
#endif

#define LAS __attribute__((address_space(3)))
typedef unsigned short bf16_t;
typedef short bf16x8 __attribute__((ext_vector_type(8)));
typedef float f32x4 __attribute__((ext_vector_type(4)));
typedef unsigned u32x4 __attribute__((ext_vector_type(4)));
typedef unsigned u32x2 __attribute__((ext_vector_type(2)));

constexpr int MTOK = 16384, DM = 1024, SEQ = 4096, NBATCH = 4, DIN = 9216, DFF = 2816, DEPTH = 2;
constexpr float ALPHA = 1.4142135623730951f;
constexpr float LN_EPS = 1e-5f;

constexpr size_t MiB = (size_t)1 << 20;
constexpr size_t WS_W1G = 0;
constexpr size_t WS_WA = 18 * MiB;
constexpr size_t WS_WB = 20 * MiB;
constexpr size_t WS_WP = 22 * MiB;
constexpr size_t WS_WO = 24 * MiB;
constexpr size_t WS_WUP = 26 * MiB;
constexpr size_t WS_WD = 37 * MiB;
constexpr size_t WS_WSP = 42 * MiB + 512 * 1024;
constexpr size_t WS_ADA = 44 * MiB;
constexpr size_t WS_B1P = 44 * MiB + 256 * 1024;
constexpr size_t WS_BAR = 44 * MiB + 512 * 1024;
constexpr size_t WS_STATS = 45 * MiB;
constexpr size_t WS_H = 48 * MiB;
constexpr size_t WS_S0 = 80 * MiB;
constexpr size_t SLOT = 32 * MiB;
constexpr size_t WS_END = WS_S0 + 6 * SLOT;

constexpr int LDS_BYTES = 131072 + 256;
constexpr int NTHREADS = 512;

struct Args {
    const float* in[25];
    float* out;
    unsigned char* ws;
    int ph_lo, ph_hi;
};

struct LArgs { const float* in[25]; float* out; unsigned char* ws; };
template <class T> __device__ __forceinline__ T* uniform_ptr(T* p) {
    const unsigned long long v = (unsigned long long)p;
    const unsigned lo = __builtin_amdgcn_readfirstlane((unsigned)v), hi = __builtin_amdgcn_readfirstlane((unsigned)(v >> 32));
    return (T*)(((unsigned long long)hi << 32) | lo);
}
__device__ __forceinline__ int tid_() { int t = threadIdx.x; asm volatile("" : "+v"(t)); return t; }
#define IN(i) uniform_ptr(a.in[i])

enum { I_X = 0, I_C, I_WADA, I_BADA, I_WIN, I_BIN, I_CONVA, I_WAOUT, I_LNVG, I_LNVB, I_WSP, I_BSP, I_WBOUT, I_WPOOL, I_PSCALE, I_WO, I_LN1G, I_LN1B,
       I_WUP, I_BUP, I_CONVF, I_CONVFB, I_WDOWN, I_LN2G, I_LN2B };

__device__ __forceinline__ float bf_lo(unsigned w) { return __uint_as_float(w << 16); }
__device__ __forceinline__ float bf_hi(unsigned w) { return __uint_as_float(w & 0xffff0000u); }
__device__ __forceinline__ unsigned pk_bf16(float lo, float hi) { unsigned r; asm("v_cvt_pk_bf16_f32 %0, %1, %2" : "=v"(r) : "v"(lo), "v"(hi)); return r; }
__device__ __forceinline__ float gelu_tanh(float x) {
    const float u2 = x * (1.5957691216f + 0.0713548163f * x * x);
    const float e = __builtin_amdgcn_exp2f(-1.4426950409f * u2);
    return x * __builtin_amdgcn_rcpf(1.0f + e);
}
__device__ __forceinline__ float sigmoid_f(float x) { const float e = __builtin_amdgcn_exp2f(-1.4426950409f * x); return __builtin_amdgcn_rcpf(1.0f + e); }
__device__ __forceinline__ void unpack8(const u32x4 w, float (&f)[8]) {
    f[0] = bf_lo(w.x); f[1] = bf_hi(w.x); f[2] = bf_lo(w.y); f[3] = bf_hi(w.y); f[4] = bf_lo(w.z); f[5] = bf_hi(w.z); f[6] = bf_lo(w.w); f[7] = bf_hi(w.w);
}
__device__ __forceinline__ u32x4 pack8(const float (&f)[8]) { u32x4 w; w.x = pk_bf16(f[0], f[1]); w.y = pk_bf16(f[2], f[3]); w.z = pk_bf16(f[4], f[5]); w.w = pk_bf16(f[6], f[7]); return w; }

constexpr int BM = 256, BK = 64, HALF = 128, HTB = HALF * BK * 2;
__device__ __forceinline__ int lds_byte(int r, int c) { const int st = (r >> 4) * 2 + (c >> 5), rr = r & 15, cc = c & 31, ob = rr * 64 + cc * 2; return st * 1024 + (ob ^ (((ob >> 9) & 1) << 5)); }
__device__ __forceinline__ void stage_rc(int b, int& R, int& C) { const int st = b / 1024, sb = b % 1024, swz = sb ^ (((sb >> 9) & 1) << 5); R = (st >> 1) * 16 + swz / 64; C = (st & 1) * 32 + (swz % 64) / 2; }
__device__ __forceinline__ int perm32(int rho) { const int n = rho >> 4, i = rho & 15; return 8 * (i >> 2) + 4 * n + (i & 3); }

enum { K_STORE = 0, K_ZCX = 1, K_BR = 2, K_RES = 3 };
enum { ACT_NONE = 0, ACT_GELU = 1, ACT_SIGMOID = 2, ACT_STATS = 4 };

struct Unit {
    const char* A; const char* B;
    int nt, code, pm, pn;
};

__device__ __forceinline__ bool static_tile(int nM, int nN, long L, int& pm, int& pn) {
    const int nwg = nM * nN; if (L >= nwg) return false;
    int wgid = (int)L; { const int q = nwg / 8, r = nwg % 8, xcd = wgid % 8, off = wgid / 8; wgid = (xcd < r ? xcd * (q + 1) : r * (q + 1) + (xcd - r) * q) + off; }
    const int nig = 8 * nN, gid = wgid / nig, fm = gid * 8, gsz = (nM - fm) < 8 ? (nM - fm) : 8;
    pm = fm + ((wgid % nig) % gsz); pn = (wgid % nig) / gsz; return true;
}

enum { GM_G1 = 0, GM_BR, GM_WO, GM_UP, GM_DOWN };
struct GSched {
    int mode, G, c;
    unsigned char* ws;
    __device__ __forceinline__ bool next(int i, Unit& u) const {
        const size_t ROWB = 256 * 1024 * 2;
        u.code = 0; u.nt = 16;
        if (mode == GM_G1) {
            if (!static_tile(64, 24, (long)i * G + c, u.pm, u.pn)) return false;
            u.A = (const char*)(ws + WS_H) + (size_t)u.pm * ROWB; u.B = (const char*)(ws + WS_W1G) + (size_t)u.pn * ROWB;
            return true;
        } else if (mode == GM_BR) {
            const int ti = i / 6, step = i - ti * 6;
            if (!static_tile(64, 4, (long)ti * G + c, u.pm, u.pn)) return false;
            const int br = step >> 1; u.code = step;
            if ((step & 1) == 0) { u.A = (const char*)(ws + WS_H) + (size_t)u.pm * ROWB; u.B = (const char*)(ws + WS_W1G) + (size_t)(24 + br * 4 + u.pn) * ROWB; }
            else if (br == 0) { u.A = (const char*)(ws + WS_S0) + (size_t)u.pm * ROWB; u.B = (const char*)(ws + WS_WA) + (size_t)u.pn * ROWB; }
            else if (br == 1) { u.A = (const char*)(ws + WS_S0 + 2 * SLOT) + (size_t)u.pm * ROWB; u.B = (const char*)(ws + WS_WB) + (size_t)u.pn * ROWB; }
            else { u.A = (const char*)(ws + WS_S0 + 5 * SLOT) + (size_t)u.pm * ROWB + (size_t)u.pn * 512; u.B = (const char*)(ws + WS_WP) + (size_t)u.pn * ROWB + (size_t)u.pn * 512; u.nt = 4; }
            return true;
        } else if (mode == GM_WO) {
            if (!static_tile(64, 4, (long)i * G + c, u.pm, u.pn)) return false;
            u.A = (const char*)(ws + WS_S0 + SLOT) + (size_t)u.pm * ROWB; u.B = (const char*)(ws + WS_WO) + (size_t)u.pn * ROWB;
            return true;
        } else if (mode == GM_UP) {
            if (!static_tile(64, 22, (long)i * G + c, u.pm, u.pn)) return false;
            u.A = (const char*)(ws + WS_H) + (size_t)u.pm * ROWB; u.B = (const char*)(ws + WS_WUP) + (size_t)u.pn * ROWB;
            return true;
        } else {
            if (!static_tile(64, 4, (long)i * G + c, u.pm, u.pn)) return false;
            u.A = (const char*)(ws + WS_S0 + 3 * SLOT) + (size_t)u.pm * (256 * (size_t)DFF * 2); u.B = (const char*)(ws + WS_WD) + (size_t)u.pn * (256 * (size_t)DFF * 2); u.nt = DFF / 64;
            return true;
        }
    }
};

struct Epi {
    const LArgs* la; int mode, layer;
    __device__ __forceinline__ void operator()(const f32x4 (&acc)[2][2][4][2], const Unit& u, int wr, int wc, int fr, int fq) const {
        const LArgs& a = *la;
        unsigned char* ws = uniform_ptr(a.ws);
        const int cb = wc * 32 + fq * 8;
        const int row0 = u.pm * BM + wr * 64 + fr;
        const int pn = u.pn;
        int kind, act = ACT_NONE, ldd = 1024;
        bf16_t* dst = nullptr; const float* bias = nullptr;
        if (mode == GM_G1) {
            kind = K_STORE; bias = (const float*)(ws + WS_B1P) + pn * 256;
            if (pn < 4) { dst = (bf16_t*)(ws + WS_S0) + pn * 256; }
            else if (pn < 12) { kind = K_ZCX; dst = (bf16_t*)(ws + WS_S0 + SLOT) + (pn - 4) * 128; }
            else if (pn < 16) { act = ACT_GELU; dst = (bf16_t*)(ws + WS_S0 + 2 * SLOT) + (pn - 12) * 256; }
            else if (pn < 20) { act = ACT_GELU | ACT_STATS; dst = (bf16_t*)(ws + WS_S0 + 3 * SLOT) + (pn - 16) * 256; }
            else { dst = (bf16_t*)(ws + WS_S0 + 4 * SLOT) + (pn - 20) * 256; }
        } else if (mode == GM_BR) {
            const int br = u.code >> 1;
            dst = (bf16_t*)(ws + WS_S0 + SLOT) + pn * 256;
            if ((u.code & 1) == 0) { kind = K_STORE; act = ACT_SIGMOID; bias = (const float*)(ws + WS_B1P) + 6144 + br * 1024 + pn * 256; }
            else { kind = K_BR; act = br; bias = (const float*)(ws + WS_S0 + 3 * SLOT) + pn * 256; }
        } else if (mode == GM_UP) {
            kind = K_STORE; ldd = DFF; bias = IN(I_BUP) + (size_t)layer * 2 * DFF + pn * 256;
            dst = (pn < 11) ? (bf16_t*)(ws + WS_S0) + pn * 256 : (bf16_t*)(ws + WS_S0 + 3 * SLOT) + (pn - 11) * 256;
        } else kind = K_RES;

        if (kind == K_STORE) {
            const float* bp = bias + cb;
            const f32x4 b00 = *(const f32x4*)(bp), b01 = *(const f32x4*)(bp + 4), b10 = *(const f32x4*)(bp + 128), b11 = *(const f32x4*)(bp + 132);
            const int actk = act & 3; const bool do_stats = (act & ACT_STATS) != 0;
            float2* stats = (float2*)(ws + WS_STATS);
#pragma unroll
            for (int ai = 0; ai < 2; ++ai)
#pragma unroll
                for (int m = 0; m < 4; ++m) {
                    const int row = row0 + ai * HALF + m * 16;
                    bf16_t* rowp = dst + (size_t)row * ldd + cb;
                    float s = 0.f, ss = 0.f;
#pragma unroll
                    for (int bj = 0; bj < 2; ++bj) {
                        f32x4 v0 = acc[ai][bj][m][0] + (bj ? b10 : b00), v1 = acc[ai][bj][m][1] + (bj ? b11 : b01);
                        if (actk == ACT_GELU) {
#pragma unroll
                            for (int j = 0; j < 4; ++j) { v0[j] = gelu_tanh(v0[j]); v1[j] = gelu_tanh(v1[j]); }
                        } else if (actk == ACT_SIGMOID) {
#pragma unroll
                            for (int j = 0; j < 4; ++j) { v0[j] = sigmoid_f(v0[j]); v1[j] = sigmoid_f(v1[j]); }
                        }
                        if (do_stats) {
#pragma unroll
                            for (int j = 0; j < 4; ++j) { s += v0[j] + v1[j]; ss += v0[j] * v0[j] + v1[j] * v1[j]; }
                        }
                        u32x4 w; w.x = pk_bf16(v0[0], v0[1]); w.y = pk_bf16(v0[2], v0[3]); w.z = pk_bf16(v1[0], v1[1]); w.w = pk_bf16(v1[2], v1[3]);
                        *(u32x4*)(rowp + bj * HALF) = w;
                    }
                    if (do_stats) {
                        s += __shfl_xor(s, 16); s += __shfl_xor(s, 32); ss += __shfl_xor(ss, 16); ss += __shfl_xor(ss, 32);
                        if (fq == 0) stats[(size_t)row * 16 + (pn - 16) * 4 + wc] = make_float2(s, ss);
                    }
                }
        } else if (kind == K_ZCX) {
            const float* bp = bias + cb;
            const f32x4 b00 = *(const f32x4*)(bp), b01 = *(const f32x4*)(bp + 4), b10 = *(const f32x4*)(bp + 128), b11 = *(const f32x4*)(bp + 132);
#pragma unroll
            for (int ai = 0; ai < 2; ++ai)
#pragma unroll
                for (int m = 0; m < 4; ++m) {
                    const int row = row0 + ai * HALF + m * 16;
                    const f32x4 p0 = (acc[ai][0][m][0] + b00) * (acc[ai][1][m][0] + b10), p1 = (acc[ai][0][m][1] + b01) * (acc[ai][1][m][1] + b11);
                    u32x4 w; w.x = pk_bf16(p0[0], p0[1]); w.y = pk_bf16(p0[2], p0[3]); w.z = pk_bf16(p1[0], p1[1]); w.w = pk_bf16(p1[2], p1[3]);
                    *(u32x4*)(dst + (size_t)row * 1024 + cb) = w;
                }
        } else if (kind == K_BR) {
            const int step = act;
            float* tm = (float*)bias;
            const float* pscale = IN(I_PSCALE) + (size_t)layer * 1024;
            f32x4 sc[2][2];
#pragma unroll
            for (int bj = 0; bj < 2; ++bj)
#pragma unroll
                for (int n = 0; n < 2; ++n) sc[bj][n] = (step == 2) ? *(const f32x4*)(pscale + pn * 256 + bj * HALF + cb + 4 * n) : (f32x4){1.f, 1.f, 1.f, 1.f};
#pragma unroll
            for (int ai = 0; ai < 2; ++ai)
#pragma unroll
                for (int m = 0; m < 4; ++m) {
                    const int row = row0 + ai * HALF + m * 16;
#pragma unroll
                    for (int bj = 0; bj < 2; ++bj) {
                        const size_t off = (size_t)row * 1024 + bj * HALF + cb;
                        const u32x4 gw = *(const u32x4*)(dst + off);
                        float g[8]; unpack8(gw, g);
                        f32x4 t0 = (f32x4){g[0], g[1], g[2], g[3]} * sc[bj][0] * acc[ai][bj][m][0];
                        f32x4 t1 = (f32x4){g[4], g[5], g[6], g[7]} * sc[bj][1] * acc[ai][bj][m][1];
                        if (step != 0) { t0 += *(const f32x4*)(tm + off); t1 += *(const f32x4*)(tm + off + 4); }
                        if (step != 2) { *(f32x4*)(tm + off) = t0; *(f32x4*)(tm + off + 4) = t1; }
                        else { u32x4 w; w.x = pk_bf16(t0[0], t0[1]); w.y = pk_bf16(t0[2], t0[3]); w.z = pk_bf16(t1[0], t1[1]); w.w = pk_bf16(t1[2], t1[3]); *(u32x4*)(dst + off) = w; }
                    }
                }
        } else {
            float* yout = uniform_ptr(a.out);
            const float* xres = (mode == GM_WO && layer == 0) ? IN(I_X) : (const float*)yout;
            const float* gp = (const float*)(ws + WS_ADA) + (size_t)layer * 4 * 6144 + (mode == GM_WO ? 2048 : 5120) + (u.pm >> 4) * 6144 + pn * 256 + cb;
            f32x4 gv[2][2];
#pragma unroll
            for (int bj = 0; bj < 2; ++bj)
#pragma unroll
                for (int n = 0; n < 2; ++n) gv[bj][n] = *(const f32x4*)(gp + bj * HALF + 4 * n);
#pragma unroll
            for (int ai = 0; ai < 2; ++ai)
#pragma unroll
                for (int m = 0; m < 4; ++m) {
                    const int row = row0 + ai * HALF + m * 16;
#pragma unroll
                    for (int bj = 0; bj < 2; ++bj) {
                        const size_t off = (size_t)row * 1024 + pn * 256 + bj * HALF + cb;
                        const f32x4 x0 = *(const f32x4*)(xres + off), x1 = *(const f32x4*)(xres + off + 4);
                        *(f32x4*)(yout + off) = x0 * ALPHA + gv[bj][0] * acc[ai][bj][m][0];
                        *(f32x4*)(yout + off + 4) = x1 * ALPHA + gv[bj][1] * acc[ai][bj][m][1];
                    }
                }
        }
    }
};

__device__ __forceinline__ void gemm_phase(LAS unsigned char* lds, const int lda, const int ldb, const GSched& S, const Epi& E) {
    const int tid = tid_(), wid = __builtin_amdgcn_readfirstlane(tid >> 6), lane = tid & 63, wr = wid >> 2, wc = wid & 3, fr = lane & 15, fq = lane >> 4;
    unsigned voffA[2], voffB[2];
#pragma unroll
    for (int i = 0; i < 2; ++i) { int R, C; stage_rc(tid * 16 + i * 8192, R, C); const int Rb = (R & ~31) + perm32(R & 31);
        voffA[i] = (unsigned)(R * lda + C) * 2u; voffB[i] = (unsigned)(Rb * ldb + C) * 2u; }
    const size_t kstep = (size_t)(BK * 2);
    const size_t hstepA = (size_t)HALF * lda * 2, hstepB = (size_t)HALF * ldb * 2;
    const unsigned ldsw = (unsigned)wid * 1024u;
    const int aoff = lds_byte(wr * 64 + fr, fq * 8), boff = lds_byte(wc * 32 + fr, fq * 8);
#define PG8_SA(b, h) (((b) * 2 + (h)) * HTB)
#define PG8_SB(b, h) ((4 + (b) * 2 + (h)) * HTB)
#define PG8_STAGE(bufoff, gbase, voff) do { _Pragma("unroll") for (int _i = 0; _i < 2; ++_i) \
        __builtin_amdgcn_global_load_lds((const unsigned*)((const char*)(gbase) + (voff)[_i]), (LAS unsigned*)(lds + (bufoff) + ldsw + _i * 8192), 16, 0, 0); } while (0)
#define PG8_LDA(dst, b, h) do { _Pragma("unroll") for (int m = 0; m < 4; ++m) _Pragma("unroll") for (int k = 0; k < 2; ++k) dst[m][k] = *(const LAS bf16x8*)(lds + PG8_SA(b, h) + aoff + m * 2048 + k * 1024); } while (0)
#define PG8_LDB(dst, b, h) do { _Pragma("unroll") for (int n = 0; n < 2; ++n) _Pragma("unroll") for (int k = 0; k < 2; ++k) dst[n][k] = *(const LAS bf16x8*)(lds + PG8_SB(b, h) + boff + n * 2048 + k * 1024); } while (0)
#define PG8_MMA(ai, bj, At, Bt) do { __builtin_amdgcn_s_setprio(1); _Pragma("unroll") for (int m = 0; m < 4; ++m) _Pragma("unroll") for (int n = 0; n < 2; ++n) _Pragma("unroll") for (int k = 0; k < 2; ++k) \
        acc[ai][bj][m][n] = __builtin_amdgcn_mfma_f32_16x16x32_bf16(Bt[n][k], At[m][k], acc[ai][bj][m][n], 0, 0, 0); __builtin_amdgcn_s_setprio(0); } while (0)
#define PG8_WAIT_V(n) asm volatile("s_waitcnt vmcnt(" #n ")" ::: "memory")
#define PG8_WAIT_L(n) asm volatile("s_waitcnt lgkmcnt(" #n ")" ::: "memory")
#define PG8_BAR __builtin_amdgcn_s_barrier()
#define PG8_SCHED __builtin_amdgcn_sched_barrier(0)
    Unit cur, nxt; int ui = 0;
    if (!S.next(0, cur)) return;
    f32x4 acc[2][2][4][2];
#pragma unroll
    for (int a = 0; a < 2; ++a)
#pragma unroll
        for (int b = 0; b < 2; ++b)
#pragma unroll
            for (int m = 0; m < 4; ++m)
#pragma unroll
                for (int n = 0; n < 2; ++n) acc[a][b][m][n] = (f32x4){0.f, 0.f, 0.f, 0.f};
    bf16x8 At[4][2], B0[2][2], B1[2][2];
    const char* cA = cur.A; const char* cB = cur.B;
    PG8_STAGE(PG8_SB(0, 0), cB, voffB); PG8_STAGE(PG8_SA(0, 0), cA, voffA); PG8_STAGE(PG8_SB(0, 1), cB + hstepB, voffB); PG8_STAGE(PG8_SA(0, 1), cA + hstepA, voffA);
    if (wr == 1) PG8_BAR;
    PG8_WAIT_V(4); PG8_BAR;
    PG8_STAGE(PG8_SB(1, 0), cB + kstep, voffB); PG8_STAGE(PG8_SA(1, 0), cA + kstep, voffA); PG8_STAGE(PG8_SB(1, 1), cB + hstepB + kstep, voffB);
    PG8_WAIT_V(6); PG8_BAR;
    for (;;) {
        const bool has_next = S.next(ui + 1, nxt);
        const char* nA = has_next ? nxt.A : cA; const char* nB = has_next ? nxt.B : cB;
        const int nt = cur.nt;
        for (int t = 0; t < nt; t += 2) {
            const bool last = (t == nt - 2);
            const char* a1 = cA + (size_t)(t + 1) * kstep;
            const char* a2 = last ? nA : cA + (size_t)(t + 2) * kstep; const char* b2 = last ? nB : cB + (size_t)(t + 2) * kstep;
            const char* a3 = a2 + kstep; const char* b3 = b2 + kstep;
            PG8_LDB(B0, 0, 0); PG8_SCHED; PG8_LDA(At, 0, 0); PG8_STAGE(PG8_SA(1, 1), a1 + hstepA, voffA);
            PG8_WAIT_L(8); PG8_BAR; PG8_WAIT_L(0); PG8_MMA(0, 0, At, B0); PG8_BAR; PG8_SCHED;
            PG8_LDB(B1, 0, 1); PG8_STAGE(PG8_SB(0, 0), b2, voffB);
            PG8_BAR; PG8_WAIT_L(0); PG8_MMA(0, 1, At, B1); PG8_BAR;
            PG8_LDA(At, 0, 1); PG8_STAGE(PG8_SA(0, 0), a2, voffA);
            PG8_BAR; PG8_WAIT_L(0); PG8_MMA(1, 0, At, B0); PG8_BAR; PG8_SCHED;
            PG8_STAGE(PG8_SB(0, 1), b2 + hstepB, voffB);
            PG8_WAIT_V(6); PG8_BAR; PG8_MMA(1, 1, At, B1); PG8_BAR;
            PG8_LDB(B0, 1, 0); PG8_SCHED; PG8_LDA(At, 1, 0); PG8_STAGE(PG8_SA(0, 1), a2 + hstepA, voffA);
            PG8_WAIT_L(8); PG8_BAR; PG8_WAIT_L(0); PG8_MMA(0, 0, At, B0); PG8_BAR; PG8_SCHED;
            PG8_LDB(B1, 1, 1); PG8_STAGE(PG8_SB(1, 0), b3, voffB);
            PG8_BAR; PG8_WAIT_L(0); PG8_MMA(0, 1, At, B1); PG8_BAR;
            PG8_LDA(At, 1, 1); PG8_STAGE(PG8_SA(1, 0), a3, voffA);
            PG8_BAR; PG8_WAIT_L(0); PG8_MMA(1, 0, At, B0); PG8_BAR; PG8_SCHED;
            PG8_STAGE(PG8_SB(1, 1), b3 + hstepB, voffB);
            PG8_WAIT_V(6); PG8_BAR; PG8_MMA(1, 1, At, B1); PG8_BAR;
        }
        E(acc, cur, wr, wc, fr, fq);
        if (!has_next) break;
#pragma unroll
        for (int a = 0; a < 2; ++a)
#pragma unroll
            for (int b = 0; b < 2; ++b)
#pragma unroll
                for (int m = 0; m < 4; ++m)
#pragma unroll
                    for (int n = 0; n < 2; ++n) acc[a][b][m][n] = (f32x4){0.f, 0.f, 0.f, 0.f};
        cur = nxt; cA = nA; cB = nB; ++ui;
    }
    PG8_WAIT_V(0);
    if (wr == 0) PG8_BAR;
    PG8_BAR;
#undef PG8_SA
#undef PG8_SB
#undef PG8_STAGE
#undef PG8_LDA
#undef PG8_LDB
#undef PG8_MMA
#undef PG8_WAIT_V
#undef PG8_WAIT_L
#undef PG8_BAR
#undef PG8_SCHED
}

__device__ __forceinline__ void conv_tile(const float* __restrict__ src, int ldn, int k0, int n0, bf16_t* __restrict__ dst, int ldk, int drow0, int dcol0, float* tile) {
    const int tid = tid_();
    {
        const int nn4 = (tid & 15) * 4, kk = tid >> 4;
#pragma unroll
        for (int p = 0; p < 2; ++p) {
            const int k = kk + 32 * p;
            const f32x4 v = *(const f32x4*)(src + (size_t)(k0 + k) * ldn + n0 + nn4);
            float* tp = tile + k * 65 + nn4; tp[0] = v[0]; tp[1] = v[1]; tp[2] = v[2]; tp[3] = v[3];
        }
    }
    __syncthreads();
    {
        const int nn = tid >> 3, kc = (tid & 7) * 8;
        float f[8];
#pragma unroll
        for (int e = 0; e < 8; ++e) f[e] = tile[(kc + e) * 65 + nn];
        *(u32x4*)(dst + (size_t)(drow0 + nn) * ldk + dcol0 + k0 + kc) = pack8(f);
    }
    __syncthreads();
}

constexpr int PREP_TILES = 2304 + 3 * 256 + 64 + 1408 + 704;
constexpr int PREP_MISC = 32 + 1;
constexpr int ADA_UNITS = 192;

__device__ __forceinline__ void prep_unit(const LArgs& a, int layer, int t, unsigned char* smem) {
    unsigned char* ws = uniform_ptr(a.ws);
    float* tile = (float*)smem;
    const int tid = tid_();
    if (t < 2304) {
        const int kt = t & 15, ntile = t >> 4, n0 = ntile * 64;
        int r;
        if (n0 < 1024) r = n0;
        else if (n0 < 2048) { const int ch = n0 - 1024; r = 1024 + 256 * (ch >> 7) + (ch & 127); }
        else if (n0 < 3072) { const int ch = n0 - 2048; r = 1024 + 256 * (ch >> 7) + 128 + (ch & 127); }
        else r = n0;
        conv_tile(IN(I_WIN) + (size_t)layer * DM * DIN, DIN, kt * 64, n0, (bf16_t*)(ws + WS_W1G), 1024, r, 0, tile); return;
    }
    t -= 2304;
    if (t < 768) {
        const int which = t >> 8, tt = t & 255, kt = tt & 15, ntile = tt >> 4;
        const float* src = (which == 0 ? IN(I_WAOUT) : which == 1 ? IN(I_WBOUT) : IN(I_WO)) + (size_t)layer * DM * DM;
        bf16_t* dst = (bf16_t*)(ws + (which == 0 ? WS_WA : which == 1 ? WS_WB : WS_WO));
        conv_tile(src, 1024, kt * 64, ntile * 64, dst, 1024, ntile * 64, 0, tile); return;
    }
    t -= 768;
    if (t < 64) {
        const int g = t >> 4, r = t & 15, kt = r & 3, ntile = r >> 2;
        conv_tile(IN(I_WPOOL) + (size_t)(layer * 4 + g) * 65536, 256, kt * 64, ntile * 64, (bf16_t*)(ws + WS_WP), 1024, 256 * g + ntile * 64, 256 * g, tile); return;
    }
    t -= 64;
    if (t < 1408) {
        const int kt = t & 15, ntile = t >> 4;
        conv_tile(IN(I_WUP) + (size_t)layer * DM * 2 * DFF, 2 * DFF, kt * 64, ntile * 64, (bf16_t*)(ws + WS_WUP), 1024, ntile * 64, 0, tile); return;
    }
    t -= 1408;
    if (t < 704) {
        const int kt = t % 44, ntile = t / 44;
        conv_tile(IN(I_WDOWN) + (size_t)layer * DFF * DM, 1024, kt * 64, ntile * 64, (bf16_t*)(ws + WS_WD), DFF, ntile * 64, 0, tile); return;
    }
    t -= 704;
    if (t < 32) {
        const int e0 = t * 4096 + tid * 8;
        const float* src = IN(I_WSP) + (size_t)layer * 131072 + e0;
        const f32x4 v0 = *(const f32x4*)src, v1 = *(const f32x4*)(src + 4);
        const int i = (e0 >> 7) & 127, j = e0 & 127;
        const bool ok = (j >> 6) <= (i >> 6);
        float f[8] = {v0[0], v0[1], v0[2], v0[3], v1[0], v1[1], v1[2], v1[3]};
        if (!ok) {
#pragma unroll
            for (int e = 0; e < 8; ++e) f[e] = 0.f;
        }
        *(u32x4*)((bf16_t*)(ws + WS_WSP) + e0) = pack8(f); return;
    }
    t -= 32;
    {
        const float* bin = IN(I_BIN) + (size_t)layer * DIN; float* b1p = (float*)(ws + WS_B1P);
        for (int r = tid; r < DIN; r += NTHREADS) {
            int src;
            if (r < 1024 || r >= 3072) src = r;
            else { const int rr = r - 1024, q = rr >> 8, w = rr & 255; src = (w < 128) ? 1024 + 128 * q + w : 2048 + 128 * q + (w - 128); }
            b1p[r] = bin[src];
        }
    }
}

__device__ __forceinline__ void ada_unit(const LArgs& a, int u, unsigned char* smem) {
    const int tid = tid_(), wid = tid >> 6, lane = tid & 63;
    float* sc = (float*)smem;
    float* red = (float*)(smem + 16384);
    const int layer = u / 96, n0 = (u % 96) * 64;
    for (int i = tid; i < 4096; i += NTHREADS) { const float c = IN(I_C)[i]; sc[i] = c * sigmoid_f(c); }
    __syncthreads();
    const float* w = IN(I_WADA) + (size_t)layer * DM * 6144 + n0 + lane;
    float acc0 = 0.f, acc1 = 0.f, acc2 = 0.f, acc3 = 0.f;
    const int kb = wid * 128;
#pragma unroll 8
    for (int k = 0; k < 128; ++k) {
        const float wv = w[(size_t)(kb + k) * 6144];
        acc0 += sc[kb + k] * wv; acc1 += sc[1024 + kb + k] * wv; acc2 += sc[2048 + kb + k] * wv; acc3 += sc[3072 + kb + k] * wv;
    }
    red[(wid * 4 + 0) * 64 + lane] = acc0; red[(wid * 4 + 1) * 64 + lane] = acc1; red[(wid * 4 + 2) * 64 + lane] = acc2; red[(wid * 4 + 3) * 64 + lane] = acc3;
    __syncthreads();
    if (tid < 256) {
        const int b = tid >> 6, n = tid & 63; float s = 0.f;
#pragma unroll
        for (int ww = 0; ww < 8; ++ww) s += red[(ww * 4 + b) * 64 + n];
        ((float*)(uniform_ptr(a.ws) + WS_ADA))[(size_t)(layer * 4 + b) * 6144 + n0 + n] = s + IN(I_BADA)[(size_t)layer * 6144 + n0 + n];
    }
    __syncthreads();
}

__device__ __forceinline__ void modulate_phase(const LArgs& a) {
    const float* x = IN(I_X); const float* ada = (const float*)(uniform_ptr(a.ws) + WS_ADA); bf16_t* H = (bf16_t*)(uniform_ptr(a.ws) + WS_H);
    const size_t nchunks = (size_t)MTOK * DM / 8;
    const int tid0 = tid_();
    for (size_t i = (size_t)blockIdx.x * NTHREADS + tid0; i < nchunks; i += (size_t)gridDim.x * NTHREADS) {
        const size_t e = i * 8; const int row = (int)(e >> 10), col = (int)(e & 1023), b = row >> 12;
        const f32x4 x0 = *(const f32x4*)(x + e), x1 = *(const f32x4*)(x + e + 4);
        const float* sh = ada + (size_t)b * 6144 + col; const float* sc = sh + 1024;
        const f32x4 s0 = *(const f32x4*)sc, s1 = *(const f32x4*)(sc + 4), h0 = *(const f32x4*)sh, h1 = *(const f32x4*)(sh + 4);
        const f32x4 y0 = x0 * (s0 + 1.0f) + h0, y1 = x1 * (s1 + 1.0f) + h1;
        u32x4 w; w.x = pk_bf16(y0[0], y0[1]); w.y = pk_bf16(y0[2], y0[3]); w.z = pk_bf16(y1[0], y1[1]); w.w = pk_bf16(y1[2], y1[3]);
        *(u32x4*)(H + e) = w;
    }
}

__device__ __forceinline__ void ln_phase(float* buf, const float* g, const float* bta, const float* mod_sh, const float* mod_sc, bf16_t* H) {
    const int tid = tid_(), wid = tid >> 6, lane = tid & 63;
    for (int row = blockIdx.x * 8 + wid; row < MTOK; row += gridDim.x * 8) {
        float* rp = buf + (size_t)row * DM + lane * 4;
        f32x4 v[4];
#pragma unroll
        for (int c = 0; c < 4; ++c) v[c] = *(const f32x4*)(rp + c * 256);
        float s = 0.f;
#pragma unroll
        for (int c = 0; c < 4; ++c) s += (v[c][0] + v[c][1]) + (v[c][2] + v[c][3]);
#pragma unroll
        for (int o = 32; o >= 1; o >>= 1) s += __shfl_xor(s, o);
        const float mean = s * (1.0f / 1024.0f);
        float q = 0.f;
#pragma unroll
        for (int c = 0; c < 4; ++c) { v[c] -= mean; q += (v[c][0] * v[c][0] + v[c][1] * v[c][1]) + (v[c][2] * v[c][2] + v[c][3] * v[c][3]); }
#pragma unroll
        for (int o = 32; o >= 1; o >>= 1) q += __shfl_xor(q, o);
        const float rstd = rsqrtf(q * (1.0f / 1024.0f) + LN_EPS);
        const int b = row >> 12;
#pragma unroll
        for (int c = 0; c < 4; ++c) {
            const int col = c * 256 + lane * 4;
            const f32x4 o = v[c] * rstd * *(const f32x4*)(g + col) + *(const f32x4*)(bta + col);
            *(f32x4*)(rp + c * 256) = o;
            if (H) {
                const f32x4 hh = o * (*(const f32x4*)(mod_sc + (size_t)b * 6144 + col) + 1.0f) + *(const f32x4*)(mod_sh + (size_t)b * 6144 + col);
                u32x2 w; w.x = pk_bf16(hh[0], hh[1]); w.y = pk_bf16(hh[2], hh[3]);
                *(u32x2*)(H + (size_t)row * DM + col) = w;
            }
        }
    }
}

__device__ __forceinline__ void conv3_gate_unit(const bf16_t* src, const bf16_t* gate, bf16_t* out, int ld, int R0, int C0, const float* w3, int wld, const float* bias, bool act_gelu) {
    const int tid = tid_(), cth = tid & 15, rth = tid >> 4;
    const int c = C0 + cth * 8, t0 = R0 + rth * 4, ts = t0 & (SEQ - 1);
    float w0[8], w1[8], w2[8], bb[8];
#pragma unroll
    for (int e = 0; e < 8; ++e) { w0[e] = w3[c + e]; w1[e] = w3[wld + c + e]; w2[e] = w3[2 * wld + c + e]; bb[e] = bias ? bias[c + e] : 0.f; }
    float xm2[8], xm1[8];
    if (ts >= 2) { unpack8(*(const u32x4*)(src + (size_t)(t0 - 2) * ld + c), xm2); unpack8(*(const u32x4*)(src + (size_t)(t0 - 1) * ld + c), xm1); }
    else {
#pragma unroll
        for (int e = 0; e < 8; ++e) { xm2[e] = 0.f; xm1[e] = 0.f; }
    }
#pragma unroll
    for (int r = 0; r < 4; ++r) {
        float x0[8], gg[8], o[8];
        unpack8(*(const u32x4*)(src + (size_t)(t0 + r) * ld + c), x0);
        unpack8(*(const u32x4*)(gate + (size_t)(t0 + r) * ld + c), gg);
#pragma unroll
        for (int e = 0; e < 8; ++e) {
            float v = w0[e] * xm2[e] + w1[e] * xm1[e] + w2[e] * x0[e] + bb[e];
            if (act_gelu) v = gelu_tanh(v);
            o[e] = gg[e] * v; xm2[e] = xm1[e]; xm1[e] = x0[e];
        }
        *(u32x4*)(out + (size_t)(t0 + r) * ld + c) = pack8(o);
    }
}

__device__ __forceinline__ void pool_unit(const bf16_t* zp, bf16_t* dout, int R0, int C0) {
    const int tid = tid_(), cth = tid & 15, rth = tid >> 4;
    const int c = C0 + cth * 8, t0 = R0 + rth * 4, ts0 = t0 & (SEQ - 1);
    const int win = 2 << (C0 >> 8);
    float s[8];
#pragma unroll
    for (int e = 0; e < 8; ++e) s[e] = 0.f;
    for (int k = 1; k < win; ++k) {
        if (ts0 - k >= 0) { float x[8]; unpack8(*(const u32x4*)(zp + (size_t)(t0 - k) * DM + c), x);
#pragma unroll
            for (int e = 0; e < 8; ++e) s[e] += x[e]; }
    }
#pragma unroll
    for (int r = 0; r < 4; ++r) {
        const int ts = ts0 + r;
        float x[8], o[8]; unpack8(*(const u32x4*)(zp + (size_t)(t0 + r) * DM + c), x);
        const float inv = 1.0f / (float)((ts + 1) < win ? (ts + 1) : win);
#pragma unroll
        for (int e = 0; e < 8; ++e) { s[e] += x[e]; o[e] = s[e] * inv - x[e]; }
        *(u32x4*)(dout + (size_t)(t0 + r) * DM + c) = pack8(o);
        if (ts - win + 1 >= 0) { float y[8]; unpack8(*(const u32x4*)(zp + (size_t)(t0 + r - win + 1) * DM + c), y);
#pragma unroll
            for (int e = 0; e < 8; ++e) s[e] -= y[e]; }
    }
}

__device__ __forceinline__ void spatial_unit(const LArgs& a, int layer, int rb, int g, unsigned char* smem) {
    unsigned char* ws = uniform_ptr(a.ws);
    const int tid = tid_(), wid = tid >> 6, lane = tid & 63;
    float* smu = (float*)smem; float* srs = smu + 128;
    bf16_t* VT = (bf16_t*)(smem + 1024);
    constexpr int LDT = 136;
    const int R0 = rb * 128, C0 = g * 128;
    const bf16_t* V = (const bf16_t*)(ws + WS_S0 + 3 * SLOT);
    bf16_t* U = (bf16_t*)(ws + WS_S0 + 2 * SLOT);
    if (tid < 128) {
        const float2* st = (const float2*)(ws + WS_STATS) + (size_t)(R0 + tid) * 16;
        float s = 0.f, ss = 0.f;
#pragma unroll
        for (int k = 0; k < 16; ++k) { const float2 p = st[k]; s += p.x; ss += p.y; }
        const float mu = s * (1.0f / 1024.0f); float var = ss * (1.0f / 1024.0f) - mu * mu; var = var > 0.f ? var : 0.f;
        smu[tid] = mu; srs[tid] = rsqrtf(var + LN_EPS);
    }
    __syncthreads();
    {
        const int cth = tid & 15, jth = tid >> 4;
        const float* lg = IN(I_LNVG) + (size_t)layer * 1024 + C0 + cth * 8; const float* lb = IN(I_LNVB) + (size_t)layer * 1024 + C0 + cth * 8;
        float gg[8], bb[8];
#pragma unroll
        for (int e = 0; e < 8; ++e) { gg[e] = lg[e]; bb[e] = lb[e]; }
#pragma unroll
        for (int p = 0; p < 4; ++p) {
            const int j = jth + 32 * p;
            float x[8]; unpack8(*(const u32x4*)(V + (size_t)(R0 + j) * DM + C0 + cth * 8), x);
            const float mu = smu[j], rs = srs[j];
#pragma unroll
            for (int e = 0; e < 8; e += 2) {
                const float y0 = (x[e] - mu) * rs * gg[e] + bb[e], y1 = (x[e + 1] - mu) * rs * gg[e + 1] + bb[e + 1];
                const unsigned w = pk_bf16(y0, y1);
                VT[(cth * 8 + e) * LDT + j] = (bf16_t)(w & 0xffffu); VT[(cth * 8 + e + 1) * LDT + j] = (bf16_t)(w >> 16);
            }
        }
    }
    __syncthreads();
    {
        const int wcg = wid & 3, wig = wid >> 2, n = lane & 15, q = lane >> 4;
        const bf16_t* W = (const bf16_t*)(ws + WS_WSP) + (size_t)g * 16384;
        f32x4 acc[2][4];
#pragma unroll
        for (int ct = 0; ct < 2; ++ct)
#pragma unroll
            for (int it = 0; it < 4; ++it) acc[ct][it] = (f32x4){0.f, 0.f, 0.f, 0.f};
#pragma unroll
        for (int ks = 0; ks < 4; ++ks) {
            const int k0 = ks * 32;
            bf16x8 af[2], bfr[4];
#pragma unroll
            for (int ct = 0; ct < 2; ++ct) af[ct] = *(const bf16x8*)(VT + (wcg * 32 + ct * 16 + n) * LDT + k0 + q * 8);
#pragma unroll
            for (int it = 0; it < 4; ++it) bfr[it] = *(const bf16x8*)(W + (wig * 64 + it * 16 + n) * 128 + k0 + q * 8);
#pragma unroll
            for (int ct = 0; ct < 2; ++ct)
#pragma unroll
                for (int it = 0; it < 4; ++it) acc[ct][it] = __builtin_amdgcn_mfma_f32_16x16x32_bf16(af[ct], bfr[it], acc[ct][it], 0, 0, 0);
        }
        const float* bsp = IN(I_BSP) + (size_t)layer * 1024 + g * 128;
#pragma unroll
        for (int it = 0; it < 4; ++it) {
            const int i = wig * 64 + it * 16 + n; const float bs = bsp[i];
#pragma unroll
            for (int ct = 0; ct < 2; ++ct) {
                bf16_t* up = U + (size_t)(R0 + i) * DM + C0 + wcg * 32 + ct * 16 + q * 4;
                const u32x2 uw = *(const u32x2*)up;
                u32x2 ow; ow.x = pk_bf16(bf_lo(uw.x) * (acc[ct][it][0] + bs), bf_hi(uw.x) * (acc[ct][it][1] + bs));
                ow.y = pk_bf16(bf_lo(uw.y) * (acc[ct][it][2] + bs), bf_hi(uw.y) * (acc[ct][it][3] + bs));
                *(u32x2*)up = ow;
            }
        }
    }
    __syncthreads();
}


#define XB_TMO      128
#define XB_XCNT(j)  (256  + 64 * (j))
#define XB_XSUB(j)  (1280 + 64 * (j))
#define XB_XGEN(j)  (2304 + 64 * (j))
#define XB_TOP      3328
#define XB_TOPGEN   3392
#define XCD_BAR_WORDS 3456
#define XB_SPIN_CAP (1u << 18)
__device__ __forceinline__ unsigned xb_ld(unsigned* p)              { return __hip_atomic_load(p, __ATOMIC_RELAXED, __HIP_MEMORY_SCOPE_AGENT); }
__device__ __forceinline__ unsigned xb_add(unsigned* p, unsigned v) { return __hip_atomic_fetch_add(p, v, __ATOMIC_RELAXED, __HIP_MEMORY_SCOPE_AGENT); }
__device__ __forceinline__ unsigned xb_xcc_id() { return (unsigned)__builtin_amdgcn_s_getreg((3 << 11) | 20) & 0xFu; }
#define XB_SPIN(cond, bar) do { unsigned _sp = 0; while (cond) { __builtin_amdgcn_s_sleep(1); \
    if ((++_sp & 255u) == 0u) { if (xb_ld(&(bar)[XB_TMO])) break; if (_sp > XB_SPIN_CAP) { atomicAdd(&(bar)[XB_TMO], 1u); break; } } } } while (0)
struct XcdBarrier { unsigned* bar; unsigned x; volatile LAS unsigned* st; };
__device__ __forceinline__ XcdBarrier xcd_barrier_post(unsigned* bar, volatile LAS unsigned* st) {
    XcdBarrier b; b.bar = bar; b.x = xb_xcc_id(); b.st = st;
    if (threadIdx.x == 0) (void)xb_add(&bar[XB_XCNT(b.x)], 1u);
    return b;
}
__device__ __forceinline__ void xcd_barrier_complete(unsigned* bar, unsigned x, unsigned& nloc, unsigned& nx) {
    const unsigned G = gridDim.x * gridDim.y * gridDim.z;
    unsigned sum, cnt, mine, sp = 0u;
    for (;;) {
        sum = 0u; cnt = 0u; mine = 0u;
#pragma unroll
        for (unsigned j = 0; j < 16; ++j) { const unsigned c = xb_ld(&bar[XB_XCNT(j)]); sum += c; cnt += (c > 0u) ? 1u : 0u; mine = (j == x) ? c : mine; }
        if (sum == G) break;
        __builtin_amdgcn_s_sleep(1);
        if ((++sp & 255u) == 0u) { if (xb_ld(&bar[XB_TMO])) break; if (sp > XB_SPIN_CAP) { atomicAdd(&bar[XB_TMO], 1u); break; } }
    }
    nloc = mine > 0u ? mine : 1u; nx = cnt > 0u ? cnt : 1u;
}
__device__ __forceinline__ void xcd_barrier(const XcdBarrier& b) {
    asm volatile("s_waitcnt vmcnt(0)" ::: "memory");
    __syncthreads();
    if (threadIdx.x == 0) {
        unsigned* bar = b.bar;
        __builtin_amdgcn_s_waitcnt(0);
        unsigned nloc = b.st[0], nx = b.st[1];
        if (nloc == 0u) { xcd_barrier_complete(bar, b.x, nloc, nx); b.st[0] = nloc; b.st[1] = nx; }
        const unsigned old = xb_add(&bar[XB_XSUB(b.x)], 1u);
        const unsigned gen = old / nloc;
        if (old + 1u == (gen + 1u) * nloc) {
            __builtin_amdgcn_fence(__ATOMIC_RELEASE, "agent");
            asm volatile("s_waitcnt vmcnt(0)" ::: "memory");
            const unsigned og = xb_add(&bar[XB_TOP], 1u);
            const unsigned tg = og / nx;
            if (og + 1u == (tg + 1u) * nx) xb_add(&bar[XB_TOPGEN], 1u);
            else XB_SPIN(xb_ld(&bar[XB_TOPGEN]) == tg, bar);
            __builtin_amdgcn_fence(__ATOMIC_ACQUIRE, "agent");
            xb_add(&bar[XB_XGEN(b.x)], 1u);
            asm volatile("s_waitcnt vmcnt(0)" ::: "memory");
        } else {
            XB_SPIN(xb_ld(&bar[XB_XGEN(b.x)]) == gen, bar);
            __builtin_amdgcn_fence(__ATOMIC_ACQUIRE, "agent");
            asm volatile("s_waitcnt vmcnt(0)" ::: "memory");
        }
    }
    __syncthreads();
}

constexpr int N_PHASES = 2 + 9 * DEPTH;

__device__ __forceinline__ void run_phase(const LArgs& a, int ph, unsigned char* smem) {
    asm volatile("" ::: "memory");
    unsigned char* ws = uniform_ptr(a.ws); float* aout = uniform_ptr(a.out);
    const int G = gridDim.x, bid = blockIdx.x;
    const float* ada = (const float*)(ws + WS_ADA);
    if (ph == 0) {
        const int total = ADA_UNITS + PREP_TILES + PREP_MISC;
        for (int u = bid; u < total; u += G) { if (u < ADA_UNITS) ada_unit(a, u, smem); else prep_unit(a, 0, u - ADA_UNITS, smem); }
        return;
    }
    if (ph == 1) { modulate_phase(a); return; }
    const int l = (ph - 2) / 9, sub = (ph - 2) % 9;
    if (sub == 0 || sub == 2 || sub == 3 || sub == 5 || sub == 7) {
        GSched S; S.G = G; S.c = bid; S.ws = ws;
        S.mode = (sub == 0) ? GM_G1 : (sub == 2) ? GM_BR : (sub == 3) ? GM_WO : (sub == 5) ? GM_UP : GM_DOWN;
        Epi E; E.la = &a; E.mode = S.mode; E.layer = l;
        const int ld = (sub == 7) ? DFF : 1024;
        gemm_phase((LAS unsigned char*)smem, ld, ld, S, E);
        return;
    }
    if (sub == 1) {
        for (int u = bid; u < 3072; u += G) {
            const int type = u >> 10, v = u & 1023, rb = v >> 3, cgp = v & 7;
            if (type == 0) conv3_gate_unit((const bf16_t*)(ws + WS_S0 + SLOT), (const bf16_t*)(ws + WS_S0), (bf16_t*)(ws + WS_S0), 1024, rb * 128, cgp * 128, IN(I_CONVA) + (size_t)l * 3 * 1024, 1024, nullptr, false);
            else if (type == 1) spatial_unit(a, l, rb, cgp, smem);
            else pool_unit((const bf16_t*)(ws + WS_S0 + 4 * SLOT), (bf16_t*)(ws + WS_S0 + 5 * SLOT), rb * 128, cgp * 128);
        }
        return;
    }
    if (sub == 4) {
        ln_phase(aout, IN(I_LN1G) + (size_t)l * 1024, IN(I_LN1B) + (size_t)l * 1024, ada + (size_t)l * 4 * 6144 + 3072, ada + (size_t)l * 4 * 6144 + 4096, (bf16_t*)(ws + WS_H));
        return;
    }
    if (sub == 6) {
        for (int u = bid; u < 128 * 22; u += G) {
            const int rb = u / 22, cgp = u % 22;
            conv3_gate_unit((const bf16_t*)(ws + WS_S0), (const bf16_t*)(ws + WS_S0 + 3 * SLOT), (bf16_t*)(ws + WS_S0 + 3 * SLOT), DFF, rb * 128, cgp * 128, IN(I_CONVF) + (size_t)l * 3 * DFF, DFF, IN(I_CONVFB) + (size_t)l * DFF, true);
        }
        return;
    }
    {
        const bool more = (l + 1 < DEPTH);
        ln_phase(aout, IN(I_LN2G) + (size_t)l * 1024, IN(I_LN2B) + (size_t)l * 1024, ada + (size_t)(l + 1) * 4 * 6144, ada + (size_t)(l + 1) * 4 * 6144 + 1024, more ? (bf16_t*)(ws + WS_H) : nullptr);
        if (more) { const int total = PREP_TILES + PREP_MISC; for (int u = bid; u < total; u += G) prep_unit(a, l + 1, u, smem); }
    }
}

__global__ void __launch_bounds__(NTHREADS, 2) fwd_kernel(Args a) {
    extern __shared__ __attribute__((aligned(16))) unsigned char smem[];
    LArgs* la = (LArgs*)(smem + 131072);
    volatile LAS unsigned* xst = (volatile LAS unsigned*)(LAS unsigned char*)(smem + 131072 + 240);
    if (threadIdx.x == 0) {
#pragma unroll
        for (int i = 0; i < 25; ++i) la->in[i] = a.in[i];
        la->out = a.out; la->ws = a.ws;
        xst[0] = 0u; xst[1] = 0u;
    }
    __syncthreads();
#if MK_ONE_LAUNCH
    cg::grid_group grid = cg::this_grid();
    { XcdBarrier xb0 = xcd_barrier_post((unsigned*)(a.ws + WS_BAR), xst); if (threadIdx.x == 0) xst[2] = xb0.x; }
#endif
    const int ph_lo = a.ph_lo, ph_hi = a.ph_hi;
    for (int ph = ph_lo; ph < ph_hi; ++ph) {
        run_phase(*la, ph, smem);
#if MK_ONE_LAUNCH
        if (ph + 1 < ph_hi) {
            if (ph == ph_lo) { __threadfence(); grid.sync(); }
            else { XcdBarrier xb; xb.bar = (unsigned*)(uniform_ptr(la->ws) + WS_BAR); xb.st = xst; xb.x = __builtin_amdgcn_readfirstlane(xst[2]); xcd_barrier(xb); }
        }
#endif
    }
}

extern "C" void kernel_launch(void* const* d_in, const int* in_sizes, int n_in, void* d_out, int out_size, void* d_ws, size_t ws_size, hipStream_t stream) {
    static int grid = 0;
    if (grid == 0) {
        if (n_in != 25 || in_sizes[0] != MTOK * DM || out_size != MTOK * DM || ws_size < WS_END) {
            fprintf(stderr, "kernel_launch: unexpected shapes / workspace (n_in %d, in0 %d, out %d, ws %zu < %zu)\n", n_in, n_in > 0 ? in_sizes[0] : -1, out_size, ws_size, (size_t)WS_END);
            grid = -1; return;
        }
        int dev = 0, cus = 0, per_cu = 0;
        hipGetDevice(&dev);
        hipDeviceGetAttribute(&cus, hipDeviceAttributeMultiprocessorCount, dev);
        hipFuncSetAttribute((const void*)fwd_kernel, hipFuncAttributeMaxDynamicSharedMemorySize, LDS_BYTES);
        hipOccupancyMaxActiveBlocksPerMultiprocessor(&per_cu, (const void*)fwd_kernel, NTHREADS, LDS_BYTES);
        if (per_cu < 1) { fprintf(stderr, "kernel_launch: occupancy query says %d blocks/CU\n", per_cu); per_cu = 1; }
        (void)hipGetLastError();
        grid = cus;
        if (grid > cus * per_cu) grid = cus * per_cu;
    }
    if (grid < 0) return;
    Args a{};
    for (int i = 0; i < 25; ++i) a.in[i] = (const float*)d_in[i];
    a.out = (float*)d_out; a.ws = (unsigned char*)d_ws;
#if MK_ONE_LAUNCH
    (void)hipMemsetAsync((unsigned char*)d_ws + WS_BAR, 0, XCD_BAR_WORDS * 4, stream);
    a.ph_lo = 0; a.ph_hi = N_PHASES;
    void* args[] = {&a};
    hipError_t e = hipLaunchCooperativeKernel((const void*)fwd_kernel, dim3(grid), dim3(NTHREADS), args, LDS_BYTES, stream);
    if (e != hipSuccess) fprintf(stderr, "cooperative launch failed: %s (grid %d)\n", hipGetErrorString(e), grid);
#else
    for (int ph = 0; ph < N_PHASES; ++ph) {
        a.ph_lo = ph; a.ph_hi = ph + 1;
        hipLaunchKernelGGL(fwd_kernel, dim3(grid), dim3(NTHREADS), LDS_BYTES, stream, a);
    }
#endif
}
```
